# Optimizing an MI355X kernel written in HIP

```python
import jax, jax.numpy as jnp
from jax import lax
import numpy as np

D_MODEL = 1024
BATCH = 32
SEQ = 2048
DEPTH = 2

HEAD_DIM = 64
N_MIX_HEADS = D_MODEL // HEAD_DIM
A_Q_HEADS = N_MIX_HEADS // 2
A_KV_HEADS = 2
B_Q_HEADS = N_MIX_HEADS - A_Q_HEADS
B_KV_HEADS = 2
MIX_WIDTH = (A_Q_HEADS + B_Q_HEADS) * HEAD_DIM
QA_W = A_Q_HEADS * HEAD_DIM
KVA_W = A_KV_HEADS * HEAD_DIM
QB_W = B_Q_HEADS * HEAD_DIM
KVB_W = B_KV_HEADS * HEAD_DIM
IN_WIDTH = QA_W + 2 * KVA_W + QB_W + 2 * KVB_W
SPLITS = [QA_W, QA_W + KVA_W, QA_W + 2 * KVA_W, QA_W + 2 * KVA_W + QB_W,
          QA_W + 2 * KVA_W + QB_W + KVB_W]

BLOCK = 128
WINDOW = 128
GRID_W = 64
ROPE_THETA = 10000.0
ROPE_FREQS = HEAD_DIM // 4

PEER_HEADS = 8
PEER_NKEYS = 128
PEER_EXPERTS = PEER_NKEYS * PEER_NKEYS
PEER_DKEY = 256
PEER_TOPK = 16
PEER_CHUNK = 128

DEEPNORM_ALPHA = (2.0 * DEPTH) ** 0.25
DEEPNORM_BETA = (8.0 * DEPTH) ** -0.25
LN_EPS = 1e-5
RMS_EPS = 1e-6
NEG_INF = -1e30

kernel_name = 'hymba_axial_window_peer_encoder'


def alibi_slopes(n):
    return (2.0 ** (-(np.arange(1, n + 1, dtype=np.float32) * 8.0 / n))).astype(np.float32)


def layer_norm(x, g, b):
    xf = x.astype(jnp.float32)
    mu = xf.mean(-1, keepdims=True)
    var = jnp.square(xf - mu).mean(-1, keepdims=True)
    return ((xf - mu) * lax.rsqrt(var + LN_EPS) * g + b).astype(x.dtype)


def rms_norm(x, g):
    xf = x.astype(jnp.float32)
    return (xf * lax.rsqrt(jnp.square(xf).mean(-1, keepdims=True) + RMS_EPS) * g).astype(x.dtype)


def axial_rope_tables(S):
    rows = S // GRID_W
    row = jnp.repeat(jnp.arange(rows), GRID_W)
    col = jnp.tile(jnp.arange(GRID_W), rows)
    pos = jnp.stack([row, col], axis=-1).astype(jnp.float32)
    inv_freq = ROPE_THETA ** (-jnp.arange(ROPE_FREQS, dtype=jnp.float32) / ROPE_FREQS)
    ang = pos[:, :, None] * inv_freq
    return jnp.cos(ang), jnp.sin(ang)


def apply_axial_rope(x, cos, sin):
    B, S, H, dh = x.shape
    xr = x.astype(jnp.float32).reshape(B, S, H, 2, 2, ROPE_FREQS)
    x1, x2 = xr[..., 0, :], xr[..., 1, :]
    c, s = cos[None, :, None], sin[None, :, None]
    out = jnp.stack([x1 * c - x2 * s, x1 * s + x2 * c], axis=-2)
    return out.reshape(B, S, H, dh).astype(x.dtype)


def global_attention(q, k, v):
    B, S, Hq, dh = q.shape
    Hkv = k.shape[2]
    G = Hq // Hkv
    nb = S // BLOCK
    scale = dh ** -0.5
    qb = q.reshape(B, nb, BLOCK, Hkv, G, dh).transpose(1, 0, 2, 3, 4, 5)

    def one_block(qblk):
        sc = jnp.einsum('bqkgd,bskd->bkgqs', qblk, k, preferred_element_type=jnp.float32) * scale
        p = jax.nn.softmax(sc, axis=-1).astype(v.dtype)
        return jnp.einsum('bkgqs,bskd->bqkgd', p, v)

    o = lax.map(one_block, qb)
    return o.transpose(1, 0, 2, 3, 4, 5).reshape(B, S, Hq, dh)


def window_sink_attention(q, k, v, sink, slopes):
    B, S, Hq, dh = q.shape
    Hkv = k.shape[2]
    G = Hq // Hkv
    nb = S // BLOCK
    span = BLOCK + 2 * WINDOW
    scale = dh ** -0.5
    qb = q.reshape(B, nb, BLOCK, Hkv, G, dh).transpose(1, 0, 2, 3, 4, 5)
    pad = ((0, 0), (WINDOW, WINDOW), (0, 0), (0, 0))
    kp = jnp.pad(k, pad)
    vp = jnp.pad(v, pad)
    slope = slopes.reshape(Hkv, G, 1, 1)
    sink_l = sink.astype(jnp.float32).reshape(Hkv, G, 1)
    q_off = jnp.arange(BLOCK)
    k_off = jnp.arange(span) - WINDOW

    def one_block(args):
        qblk, j = args
        start = j * BLOCK
        kb = lax.dynamic_slice_in_dim(kp, start, span, axis=1)
        vb = lax.dynamic_slice_in_dim(vp, start, span, axis=1)
        t = start + q_off
        s_pos = start + k_off
        dist = jnp.abs(t[:, None] - s_pos[None, :])
        valid = (dist <= WINDOW) & (s_pos >= 0)[None, :] & (s_pos < S)[None, :]
        sc = jnp.einsum('bqkgd,bskd->bkgqs', qblk, kb, preferred_element_type=jnp.float32) * scale
        sc = sc - slope * dist.astype(jnp.float32)
        sc = jnp.where(valid, sc, NEG_INF)
        m = jnp.maximum(sc.max(-1), sink_l)
        p = jnp.exp(sc - m[..., None])
        denom = p.sum(-1) + jnp.exp(sink_l - m)
        p = (p / denom[..., None]).astype(v.dtype)
        return jnp.einsum('bkgqs,bskd->bqkgd', p, vb)

    o = lax.map(one_block, (qb, jnp.arange(nb)))
    return o.transpose(1, 0, 2, 3, 4, 5).reshape(B, S, Hq, dh)


def peer_ffn(x, wq, sub_keys, u, v):
    B, S, D = x.shape
    xt = x.reshape(-1, PEER_CHUNK, D)
    half = PEER_DKEY // 2

    def chunk(xc):
        q = (xc @ wq).reshape(PEER_CHUNK, PEER_HEADS, 2, half)
        sc = jnp.einsum('chpd,hpnd->chpn', q, sub_keys, preferred_element_type=jnp.float32)
        s1, i1 = lax.top_k(sc[:, :, 0], PEER_TOPK)
        s2, i2 = lax.top_k(sc[:, :, 1], PEER_TOPK)
        cand = (s1[..., :, None] + s2[..., None, :]).reshape(PEER_CHUNK, PEER_HEADS, PEER_TOPK * PEER_TOPK)
        cidx = (i1[..., :, None] * PEER_NKEYS + i2[..., None, :]).reshape(PEER_CHUNK, PEER_HEADS, PEER_TOPK * PEER_TOPK)
        top_s, pos = lax.top_k(cand, PEER_TOPK)
        eidx = jnp.take_along_axis(cidx, pos, axis=-1)
        g = jax.nn.softmax(top_s, axis=-1)
        u_sel = jnp.take(u, eidx, axis=0)
        a = jax.nn.gelu(jnp.einsum('chkd,cd->chk', u_sel, xc, preferred_element_type=jnp.float32), approximate=False)
        w = (g * a).astype(x.dtype)
        v_sel = jnp.take(v, eidx, axis=0)
        return jnp.einsum('chk,chkd->cd', w, v_sel)

    return lax.map(chunk, xt).reshape(B, S, D)


def setup_inputs(seed: int = 0) -> dict:
    key = jax.random.key(seed)
    ks = jax.random.split(key, 24)
    L, D = DEPTH, D_MODEL
    beta = DEEPNORM_BETA

    def nrm(k, shape, std):
        return jax.random.normal(k, shape, jnp.float32) * std

    x = nrm(ks[0], (BATCH, SEQ, D), 1.0)
    ln_in_g = 1.0 + nrm(ks[1], (D,), 0.02)
    ln_in_b = nrm(ks[2], (D,), 0.02)
    col_scale = jnp.concatenate([
        jnp.ones((QA_W + KVA_W,), jnp.float32), jnp.full((KVA_W,), beta, jnp.float32),
        jnp.ones((QB_W + KVB_W,), jnp.float32), jnp.full((KVB_W,), beta, jnp.float32)])
    w_in = nrm(ks[3], (L, D, IN_WIDTH), D ** -0.5) * col_scale
    qn_g = 1.0 + nrm(ks[4], (L, HEAD_DIM), 0.02)
    kn_g = 1.0 + nrm(ks[5], (L, HEAD_DIM), 0.02)
    sink = nrm(ks[6], (L, B_Q_HEADS), 0.5)
    gn_a_g = 1.0 + nrm(ks[7], (L, QA_W), 0.02)
    gn_b_g = 1.0 + nrm(ks[8], (L, QB_W), 0.02)
    w_o = nrm(ks[9], (L, MIX_WIDTH, D), beta * MIX_WIDTH ** -0.5)
    ln1_g = 1.0 + nrm(ks[10], (L, D), 0.02)
    ln1_b = nrm(ks[11], (L, D), 0.02)
    peer_wq = nrm(ks[12], (L, D, PEER_HEADS * PEER_DKEY), D ** -0.5)
    peer_keys = nrm(ks[13], (L, PEER_HEADS, 2, PEER_NKEYS, PEER_DKEY // 2), (PEER_DKEY // 2) ** -0.5)
    peer_u = nrm(ks[14], (L, PEER_EXPERTS, D), D ** -0.5)
    peer_v = nrm(ks[15], (L, PEER_EXPERTS, D), beta * (PEER_HEADS * PEER_TOPK) ** -0.5)
    ln2_g = 1.0 + nrm(ks[16], (L, D), 0.02)
    ln2_b = nrm(ks[17], (L, D), 0.02)
    return {'x': x, 'ln_in_g': ln_in_g, 'ln_in_b': ln_in_b, 'w_in': w_in,
            'qn_g': qn_g, 'kn_g': kn_g, 'sink': sink, 'gn_a_g': gn_a_g, 'gn_b_g': gn_b_g,
            'w_o': w_o, 'ln1_g': ln1_g, 'ln1_b': ln1_b, 'peer_wq': peer_wq,
            'peer_keys': peer_keys, 'peer_u': peer_u, 'peer_v': peer_v,
            'ln2_g': ln2_g, 'ln2_b': ln2_b}


def reference(x, ln_in_g, ln_in_b, w_in, qn_g, kn_g, sink, gn_a_g, gn_b_g, w_o,
              ln1_g, ln1_b, peer_wq, peer_keys, peer_u, peer_v, ln2_g, ln2_b):
    B, S, D = x.shape
    cos, sin = axial_rope_tables(S)
    slopes = jnp.asarray(alibi_slopes(B_Q_HEADS))
    h = layer_norm(x, ln_in_g, ln_in_b)
    for l in range(DEPTH):
        proj = h @ w_in[l]
        qa, ka, va, qb, kb, vb = jnp.split(proj, SPLITS, axis=-1)
        qa = qa.reshape(B, S, A_Q_HEADS, HEAD_DIM)
        ka = ka.reshape(B, S, A_KV_HEADS, HEAD_DIM)
        va = va.reshape(B, S, A_KV_HEADS, HEAD_DIM)
        qb = qb.reshape(B, S, B_Q_HEADS, HEAD_DIM)
        kb = kb.reshape(B, S, B_KV_HEADS, HEAD_DIM)
        vb = vb.reshape(B, S, B_KV_HEADS, HEAD_DIM)
        qa = apply_axial_rope(rms_norm(qa, qn_g[l]), cos, sin)
        ka = apply_axial_rope(rms_norm(ka, kn_g[l]), cos, sin)
        oa = global_attention(qa, ka, va)
        ob = window_sink_attention(qb, kb, vb, sink[l], slopes)
        oa = rms_norm(oa, gn_a_g[l].reshape(A_Q_HEADS, HEAD_DIM)).reshape(B, S, QA_W)
        ob = rms_norm(ob, gn_b_g[l].reshape(B_Q_HEADS, HEAD_DIM)).reshape(B, S, QB_W)
        mix = jnp.concatenate([oa, ob], axis=-1) @ w_o[l]
        h = layer_norm(DEEPNORM_ALPHA * h + mix, ln1_g[l], ln1_b[l])
        ffn = peer_ffn(h, peer_wq[l], peer_keys[l], peer_u[l], peer_v[l])
        h = layer_norm(DEEPNORM_ALPHA * h + ffn, ln2_g[l], ln2_b[l])
    return h
```

```cpp
#include <hip/hip_runtime.h>
#include <hip/hip_cooperative_groups.h>
#include <stdint.h>
#include <cstdio>
namespace cg = cooperative_groups;

typedef unsigned short u16;
typedef __attribute__((ext_vector_type(8))) short bf16x8;
typedef __attribute__((ext_vector_type(4))) float f32x4;
typedef __attribute__((ext_vector_type(16))) float f32x16;
typedef float f32x2_t __attribute__((ext_vector_type(2)));
typedef uint32_t u32x4 __attribute__((ext_vector_type(4)));
typedef __bf16 bf16x2_t __attribute__((ext_vector_type(2)));

#define DI __device__ __forceinline__
#define MFMA32(a, b, c) __builtin_amdgcn_mfma_f32_32x32x16_bf16((a), (b), (c), 0, 0, 0)
#define MFMA16(a, b, c) __builtin_amdgcn_mfma_f32_16x16x32_bf16((a), (b), (c), 0, 0, 0)

constexpr int T_TOK = 65536;
constexpr int DM = 1024;
constexpr int SEQ = 2048;
constexpr int NLAYER = 2;
constexpr int LSTR = 72;
constexpr float ALPHA = 1.41421356237f;
constexpr float LOG2E = 1.44269504089f;
constexpr float QSCALE = 0.125f * LOG2E;
constexpr int NEXP = 16384;

constexpr size_t al256(size_t x) { return (x + 255) & ~(size_t)255; }
constexpr size_t OFF_hb = 0;
constexpr size_t OFF_qbuf = OFF_hb + al256((size_t)T_TOK * DM * 2);
constexpr size_t OFF_kbuf = OFF_qbuf + al256((size_t)2 * T_TOK * 8 * 64 * 2);
constexpr size_t OFF_vtbuf = OFF_kbuf + al256((size_t)2 * T_TOK * 2 * 64 * 2);
constexpr size_t OFF_ob = OFF_vtbuf + al256((size_t)2 * T_TOK * 2 * 64 * 2);
constexpr size_t OFF_yb = OFF_ob + al256((size_t)T_TOK * DM * 2);
constexpr size_t OFF_tk = OFF_yb + al256((size_t)T_TOK * DM * 2);
constexpr size_t OFF_uq = OFF_tk + al256((size_t)T_TOK * 16 * 16 * 4);
constexpr size_t OFF_vq = OFF_uq + al256((size_t)NLAYER * NEXP * DM);
constexpr size_t OFF_uscale = OFF_vq + al256((size_t)NLAYER * NEXP * DM);
constexpr size_t OFF_vscale = OFF_uscale + al256((size_t)NLAYER * NEXP * 4);
constexpr size_t OFF_xq = OFF_vscale + al256((size_t)NLAYER * NEXP * 4);
constexpr size_t OFF_xscale = OFF_xq + al256((size_t)T_TOK * DM);
constexpr size_t OFF_sel_e = OFF_xscale + al256((size_t)T_TOK * 4);
constexpr size_t OFF_sel_g = OFF_sel_e + al256((size_t)T_TOK * 128 * 2);
constexpr size_t OFF_WinT = OFF_sel_g + al256((size_t)T_TOK * 128 * 4);
constexpr size_t OFF_WoT = OFF_WinT + al256((size_t)NLAYER * 1536 * DM * 2);
constexpr size_t OFF_WqT = OFF_WoT + al256((size_t)NLAYER * 1024 * DM * 2);
constexpr size_t OFF_keysP = OFF_WqT + al256((size_t)NLAYER * 2048 * DM * 2);
constexpr size_t OFF_wqP = OFF_keysP + al256((size_t)NLAYER * 8 * 2 * 128 * 128 * 2);
constexpr size_t OFF_rope = OFF_wqP + al256((size_t)NLAYER * 2048 * DM * 2);
constexpr size_t OFF_bar = OFF_rope + al256((size_t)SEQ * 32 * 2 * 4);
constexpr size_t WS_TOTAL = OFF_bar + al256((size_t)3456 * 4);

struct Params {
  const float *x, *ln_in_g, *ln_in_b, *w_in, *qn_g, *kn_g, *sink, *gn_a_g, *gn_b_g, *w_o, *ln1_g, *ln1_b,
      *peer_wq, *peer_keys, *peer_u, *peer_v, *ln2_g, *ln2_b;
  float* out;
  char* ws;
  DI u16* hb() const { return (u16*)(ws + OFF_hb); }
  DI u16* qbuf() const { return (u16*)(ws + OFF_qbuf); }
  DI u16* kbuf() const { return (u16*)(ws + OFF_kbuf); }
  DI u16* vtbuf() const { return (u16*)(ws + OFF_vtbuf); }
  DI u16* ob() const { return (u16*)(ws + OFF_ob); }
  DI u16* yb() const { return (u16*)(ws + OFF_yb); }
  DI uint32_t* tk() const { return (uint32_t*)(ws + OFF_tk); }
  DI uint8_t* uq() const { return (uint8_t*)(ws + OFF_uq); }
  DI uint8_t* vq() const { return (uint8_t*)(ws + OFF_vq); }
  DI float* uscale() const { return (float*)(ws + OFF_uscale); }
  DI float* vscale() const { return (float*)(ws + OFF_vscale); }
  DI uint8_t* xq() const { return (uint8_t*)(ws + OFF_xq); }
  DI float* xscale() const { return (float*)(ws + OFF_xscale); }
  DI u16* sel_e() const { return (u16*)(ws + OFF_sel_e); }
  DI float* sel_g() const { return (float*)(ws + OFF_sel_g); }
  DI u16* WinT() const { return (u16*)(ws + OFF_WinT); }
  DI u16* WoT() const { return (u16*)(ws + OFF_WoT); }
  DI u16* WqT() const { return (u16*)(ws + OFF_WqT); }
  DI u16* keysP() const { return (u16*)(ws + OFF_keysP); }
  DI u16* wqP() const { return (u16*)(ws + OFF_wqP); }
  DI float* rope() const { return (float*)(ws + OFF_rope); }
  DI unsigned* bar() const { return (unsigned*)(ws + OFF_bar); }
  DI u16* partial() const { return (u16*)(ws + OFF_qbuf); }
  DI float* wbuf() const { return (float*)(ws + OFF_tk); }
};

DI uint32_t pk2(float lo, float hi) {
  f32x2_t v = {lo, hi};
  bf16x2_t b = __builtin_convertvector(v, bf16x2_t);
  return __builtin_bit_cast(uint32_t, b);
}
DI u16 f2bf(float x) { return (u16)(pk2(x, 0.f) & 0xffffu); }
DI int tid_from(int wave_s) {
  int lane;
  asm volatile("v_mbcnt_lo_u32_b32 %0, -1, 0\n\tv_mbcnt_hi_u32_b32 %0, -1, %0" : "=v"(lane));
  return wave_s * 64 + lane;
}
#define tid_opaque() tid_from(WAVE_S)
DI float bflo(uint32_t u) { return __uint_as_float(u << 16); }
DI float bfhi(uint32_t u) { return __uint_as_float(u & 0xffff0000u); }
DI int lane_opaque() { int l; asm volatile("v_mbcnt_lo_u32_b32 %0, -1, 0\n\tv_mbcnt_hi_u32_b32 %0, -1, %0" : "=v"(l)); return l; }
DI float shx(float v, int m, int lane) { return __int_as_float(__builtin_amdgcn_ds_bpermute((lane ^ m) << 2, __float_as_int(v))); }
DI int shxi(int v, int m, int lane) { return __builtin_amdgcn_ds_bpermute((lane ^ m) << 2, v); }
DI float wave_sum(float v) {
  const int ln = lane_opaque();
#pragma unroll
  for (int o = 32; o > 0; o >>= 1) v += shx(v, o, ln);
  return v;
}
DI float xhalf(float v) { return shx(v, 32, lane_opaque()); }
DI int swz16(int s) { return (s & ~12) | ((s & 4) << 1) | ((s & 8) >> 1); }
DI bf16x8 pack8(const f32x16& x, int s) {
  uint4 p;
  p.x = pk2(x[8 * s + 0], x[8 * s + 1]);
  p.y = pk2(x[8 * s + 2], x[8 * s + 3]);
  p.z = pk2(x[8 * s + 4], x[8 * s + 5]);
  p.w = pk2(x[8 * s + 6], x[8 * s + 7]);
  return __builtin_bit_cast(bf16x8, p);
}
DI uint32_t pk4_fp8(float a, float b, float c, float d) {
  int r = __builtin_amdgcn_cvt_pk_fp8_f32(a, b, 0, false);
  r = __builtin_amdgcn_cvt_pk_fp8_f32(c, d, r, true);
  return (uint32_t)r;
}
DI uint32_t pk4_i8(float a, float b, float c, float d) {
  const int i0 = __float2int_rn(a), i1 = __float2int_rn(b), i2 = __float2int_rn(c), i3 = __float2int_rn(d);
  return (uint32_t)(i0 & 0xff) | ((uint32_t)(i1 & 0xff) << 8) | ((uint32_t)(i2 & 0xff) << 16) | ((uint32_t)i3 << 24);
}
DI void ins16(float (&t)[16], float x) {
#pragma unroll
  for (int i = 15; i >= 1; --i) t[i] = __builtin_amdgcn_fmed3f(t[i - 1], t[i], x);
  t[0] = fmaxf(t[0], x);
}
DI void ins16n(float (&t)[16], float x, int nf) {
#pragma unroll
  for (int i = 15; i >= 1; --i)
    if (i <= nf) t[i] = __builtin_amdgcn_fmed3f(t[i - 1], t[i], x);
  t[0] = fmaxf(t[0], x);
}

template <int SRC, bool Q8, bool OUTF>
DI void ln_rows(const void* __restrict__ srcv, const u16* res, u16* dstb, uint32_t* __restrict__ dstq, float* __restrict__ xsc, float* __restrict__ dstf,
                const float* __restrict__ g, const float* __restrict__ b, int nrows, const int WAVE_S) {
  const int tid = tid_opaque();
  const int lane = tid & 63;
  const int gw = (blockIdx.x * 256 + tid) >> 6;
  const int nw = gridDim.x * 4;
  f32x4 g4[4], b4[4];
#pragma unroll
  for (int i = 0; i < 2; ++i)
#pragma unroll
    for (int hh = 0; hh < 2; ++hh) {
      g4[2 * i + hh] = *(const f32x4*)(g + 512 * i + 8 * lane + 4 * hh);
      b4[2 * i + hh] = *(const f32x4*)(b + 512 * i + 8 * lane + 4 * hh);
    }
  constexpr int NR = (SRC == 0) ? 4 : 2;
  auto load = [&](int row, u32x4 (&sa)[NR], u32x4 (&ra)[2]) {
    row = row < nrows ? row : nrows - 1;
    if (SRC == 0) {
      const float* sp = (const float*)srcv + (size_t)row * DM + 8 * lane;
#pragma unroll
      for (int i = 0; i < 2; ++i) { sa[2 * i] = *(const u32x4*)(sp + 512 * i); sa[2 * i + 1] = *(const u32x4*)(sp + 512 * i + 4); }
    } else {
      const u16* sp = (const u16*)srcv + (size_t)row * DM + 8 * lane;
      const u16* rp = res + (size_t)row * DM + 8 * lane;
#pragma unroll
      for (int i = 0; i < 2; ++i) { sa[i] = *(const u32x4*)(sp + 512 * i); ra[i] = *(const u32x4*)(rp + 512 * i); }
    }
  };
  auto process = [&](int row, const u32x4 (&sa)[NR], const u32x4 (&ra)[2]) {
    f32x4 v[4];
    if (SRC == 0) {
#pragma unroll
      for (int q = 0; q < 4; ++q) v[q] = __builtin_bit_cast(f32x4, sa[q]);
    } else {
#pragma unroll
      for (int i = 0; i < 2; ++i)
#pragma unroll
        for (int hh = 0; hh < 2; ++hh) {
          const uint32_t s0 = sa[i][2 * hh], s1 = sa[i][2 * hh + 1], r0 = ra[i][2 * hh], r1 = ra[i][2 * hh + 1];
          v[2 * i + hh] = (f32x4){ALPHA * bflo(r0) + bflo(s0), ALPHA * bfhi(r0) + bfhi(s0), ALPHA * bflo(r1) + bflo(s1), ALPHA * bfhi(r1) + bfhi(s1)};
        }
    }
    float sum = 0.f;
#pragma unroll
    for (int q = 0; q < 4; ++q) sum += v[q][0] + v[q][1] + v[q][2] + v[q][3];
    const float mu = wave_sum(sum) * (1.f / DM);
    float sq = 0.f;
#pragma unroll
    for (int q = 0; q < 4; ++q) {
      v[q] -= mu;
      sq += v[q][0] * v[q][0] + v[q][1] * v[q][1] + v[q][2] * v[q][2] + v[q][3] * v[q][3];
    }
    const float rstd = rsqrtf(wave_sum(sq) * (1.f / DM) + 1e-5f);
    float am = 0.f;
#pragma unroll
    for (int q = 0; q < 4; ++q) {
      v[q] = v[q] * rstd * g4[q] + b4[q];
      if (Q8) am = fmaxf(am, fmaxf(fmaxf(fabsf(v[q][0]), fabsf(v[q][1])), fmaxf(fabsf(v[q][2]), fabsf(v[q][3]))));
    }
#pragma unroll
    for (int i = 0; i < 2; ++i) {
      u32x4 w = {pk2(v[2 * i][0], v[2 * i][1]), pk2(v[2 * i][2], v[2 * i][3]), pk2(v[2 * i + 1][0], v[2 * i + 1][1]), pk2(v[2 * i + 1][2], v[2 * i + 1][3])};
      if (dstb != nullptr) *(u32x4*)(dstb + (size_t)row * DM + 512 * i + 8 * lane) = w;
    }
    if (OUTF) {
      if (dstf != nullptr) {
#pragma unroll
        for (int q = 0; q < 4; ++q) *(f32x4*)(dstf + (size_t)row * DM + 512 * (q >> 1) + 8 * lane + 4 * (q & 1)) = v[q];
      }
    }
    if (Q8) {
#pragma unroll
      for (int o = 32; o > 0; o >>= 1) am = fmaxf(am, shx(am, o, lane));
      am = fmaxf(am, 1e-20f);
      const float inv = 127.f / am;
#pragma unroll
      for (int i = 0; i < 2; ++i) {
        const int sl = 4 * i + (lane >> 4);
        uint2 w = make_uint2(pk4_i8(v[2 * i][0] * inv, v[2 * i][1] * inv, v[2 * i][2] * inv, v[2 * i][3] * inv),
                             pk4_i8(v[2 * i + 1][0] * inv, v[2 * i + 1][1] * inv, v[2 * i + 1][2] * inv, v[2 * i + 1][3] * inv));
        *(uint2*)((char*)dstq + ((size_t)sl * T_TOK + row) * 128 + (lane & 15) * 8) = w;
      }
      if (lane == 0) xsc[row] = am * (1.f / 127.f);
    }
  };
  u32x4 sA[NR], sB[NR], rA[2], rB[2];
  int row = gw;
  if (row >= nrows) return;
  load(row, sA, rA);
  while (true) {
    load(row + nw, sB, rB);
    process(row, sA, rA);
    row += nw;
    if (row >= nrows) break;
    load(row + nw, sA, rA);
    process(row, sB, rB);
    row += nw;
    if (row >= nrows) break;
  }
}

template <bool I8>
DI void quant_rows(const float* __restrict__ src, uint32_t* __restrict__ dst, float* __restrict__ scale, int nrows, const int WAVE_S) {
  const int tidq = tid_opaque();
  const int lane = tidq & 63;
  const int gw = (blockIdx.x * 256 + tidq) >> 6;
  const int nw = gridDim.x * 4;
  for (int row = gw; row < nrows; row += nw) {
    const float4* s4 = (const float4*)(src + (size_t)row * DM);
    float4 v[4];
#pragma unroll
    for (int i = 0; i < 4; ++i) v[i] = s4[lane + 64 * i];
    float am = 0.f;
#pragma unroll
    for (int i = 0; i < 4; ++i) am = fmaxf(am, fmaxf(fmaxf(fabsf(v[i].x), fabsf(v[i].y)), fmaxf(fabsf(v[i].z), fabsf(v[i].w))));
#pragma unroll
    for (int o = 32; o > 0; o >>= 1) am = fmaxf(am, shx(am, o, lane));
    am = fmaxf(am, 1e-20f);
    const float qmax = I8 ? 127.f : 224.f;
    const float inv = qmax / am;
    const int l = row / NEXP, e = row % NEXP;
#pragma unroll
    for (int i = 0; i < 4; ++i) {
      const int sl = 2 * i + (lane >> 5);
      dst[((size_t)(l * 8 + sl) * NEXP + e) * 32 + (lane & 31)] = I8 ? pk4_i8(v[i].x * inv, v[i].y * inv, v[i].z * inv, v[i].w * inv)
                                                                    : pk4_fp8(v[i].x * inv, v[i].y * inv, v[i].z * inv, v[i].w * inv);
    }
    if (lane == 0) scale[row] = am / qmax;
  }
}

DI void transpose_cvt(const float* __restrict__ src, u16* __restrict__ dst, int N, float* lds, const int WAVE_S) {
  const int tilesN = N / 64;
  const int ntiles = NLAYER * 16 * tilesN;
  const int tidt = tid_opaque();
  const int c = tidt & 63, r0 = tidt >> 6;
  for (int t = blockIdx.x; t < ntiles; t += gridDim.x) {
    const int l = t / (16 * tilesN);
    const int r = t % (16 * tilesN);
    const int kt = r / tilesN, nt = r % tilesN;
    const float* s = src + ((size_t)l * DM + kt * 64) * N + nt * 64;
    __syncthreads();
#pragma unroll
    for (int it = 0; it < 16; ++it) { const int kr = r0 + 4 * it; lds[kr * 65 + c] = s[(size_t)kr * N + c]; }
    __syncthreads();
    u16* d = dst + ((size_t)l * N + nt * 64) * DM + kt * 64;
#pragma unroll
    for (int it = 0; it < 16; ++it) { const int nr = r0 + 4 * it; d[(size_t)nr * DM + c] = f2bf(lds[c * 65 + nr]); }
  }
}

DI void prologue(const Params& p, float* ldsf, const int WAVE_S) {
  ln_rows<0, false, false>(p.x, nullptr, p.hb(), nullptr, nullptr, nullptr, p.ln_in_g, p.ln_in_b, T_TOK, WAVE_S);
  quant_rows<true>(p.peer_u, (uint32_t*)p.uq(), p.uscale(), NLAYER * NEXP, WAVE_S);
  quant_rows<false>(p.peer_v, (uint32_t*)p.vq(), p.vscale(), NLAYER * NEXP, WAVE_S);
  transpose_cvt(p.w_in, p.WinT(), 1536, ldsf, WAVE_S);
  transpose_cvt(p.w_o, p.WoT(), 1024, ldsf, WAVE_S);
  const int gt = blockIdx.x * 256 + tid_opaque(), gn = gridDim.x * 256;
  for (int i = gt; i < NLAYER * 8 * 2 * 128 * 128; i += gn) p.keysP()[i] = f2bf(p.peer_keys[i]);
  for (int i4 = gt; i4 < NLAYER * DM * 2048 / 4; i4 += gn) {
    const int i = i4 * 4;
    const int qcol = i & 2047, k = (i >> 11) & 1023, l = i >> 21;
    const float4 v = ((const float4*)p.peer_wq)[i4];
    *(uint2*)(p.wqP() + (((size_t)(l * 16 + (qcol >> 7)) * 1024 + k) * 128 + (qcol & 127))) = make_uint2(pk2(v.x, v.y), pk2(v.z, v.w));
  }
  for (int i = gt; i < SEQ * 32; i += gn) {
    const int s = i >> 5, a = (i >> 4) & 1, f = i & 15;
    const float pos = (float)(a ? (s & 63) : (s >> 6));
    const float inv = powf(10000.0f, -(float)f / 16.0f);
    const float ang = pos * inv;
    p.rope()[i] = cosf(ang);
    p.rope()[SEQ * 32 + i] = sinf(ang);
  }
}

template <int TI, int TJ, int NKT = 16, int RS = DM>
DI void gemm_tile(const u16* __restrict__ X, const u16* __restrict__ Y, f32x16 (&acc)[TI][TJ], u16* lds, int wi0, int wj0, const int WAVE_S) {
  const int tid = tid_opaque(), lane = tid & 63;
  u16* Xs = lds;
  u16* Ys = lds + 128 * LSTR;
  const int lr = tid >> 3, lc = (tid & 7) * 8;
  const u16* xg = X + (size_t)lr * RS + lc;
  const u16* yg = Y + (size_t)lr * RS + lc;
  u32x4 xr[4], yr[4];
#pragma unroll
  for (int it = 0; it < 4; ++it) {
    xr[it] = *(const u32x4*)(xg + (size_t)it * 32 * RS);
    yr[it] = *(const u32x4*)(yg + (size_t)it * 32 * RS);
  }
#pragma unroll
  for (int a = 0; a < TI; ++a)
#pragma unroll
    for (int b = 0; b < TJ; ++b)
#pragma unroll
      for (int r = 0; r < 16; ++r) acc[a][b][r] = 0.f;
  const int fr = lane & 31, fh = (lane >> 5) * 8;
  for (int kt = 0; kt < NKT; ++kt) {
    __syncthreads();
#pragma unroll
    for (int it = 0; it < 4; ++it) {
      *(u32x4*)(Xs + (lr + 32 * it) * LSTR + lc) = xr[it];
      *(u32x4*)(Ys + (lr + 32 * it) * LSTR + lc) = yr[it];
    }
    __syncthreads();
    if (kt + 1 < NKT) {
#pragma unroll
      for (int it = 0; it < 4; ++it) {
        xr[it] = *(const u32x4*)(xg + (size_t)it * 32 * RS + (kt + 1) * 64);
        yr[it] = *(const u32x4*)(yg + (size_t)it * 32 * RS + (kt + 1) * 64);
      }
    }
#pragma unroll
    for (int ks = 0; ks < 4; ++ks) {
      bf16x8 af[TI], bfr[TJ];
#pragma unroll
      for (int a = 0; a < TI; ++a) af[a] = *(const bf16x8*)(Xs + (wi0 + a * 32 + fr) * LSTR + ks * 16 + fh);
#pragma unroll
      for (int b = 0; b < TJ; ++b) bfr[b] = *(const bf16x8*)(Ys + (wj0 + b * 32 + fr) * LSTR + ks * 16 + fh);
#pragma unroll
      for (int a = 0; a < TI; ++a)
#pragma unroll
        for (int b = 0; b < TJ; ++b) acc[a][b] = MFMA32(af[a], bfr[b], acc[a][b]);
    }
  }
}

DI int next_item(unsigned* ctr, const int WAVE_S) {
  __shared__ int s_item;
  __syncthreads();
  if (tid_opaque() == 0) s_item = (int)__hip_atomic_fetch_add(ctr, 1u, __ATOMIC_RELAXED, __HIP_MEMORY_SCOPE_AGENT);
  __syncthreads();
  return s_item;
}

DI void fold_peer_weights(const Params& p, u16* lds, const int WAVE_S) {
  const int tid0 = tid_opaque();
  const int lane = tid0 & 63, wave = tid0 >> 6;
  const int r = lane & 31, h = lane >> 5;
  const int wi0 = (wave >> 1) * 64, wj0 = (wave & 1) * 64;
  for (int t = blockIdx.x; t < NLAYER * 16 * 8; t += gridDim.x) {
    const int lhp = t >> 3, kb = t & 7;
    f32x16 acc[2][2];
    gemm_tile<2, 2, 2, 128>(p.wqP() + ((size_t)lhp * 1024 + kb * 128) * 128, p.keysP() + (size_t)lhp * 128 * 128, acc, lds, wi0, wj0, WAVE_S);
    __syncthreads();
    u16* wl = lds + wave * 64 * LSTR;
#pragma unroll
    for (int tj = 0; tj < 2; ++tj)
#pragma unroll
      for (int ti = 0; ti < 2; ++ti)
#pragma unroll
        for (int g4 = 0; g4 < 4; ++g4)
          *(uint2*)(wl + (tj * 32 + r) * LSTR + ti * 32 + 8 * g4 + 4 * h) =
              make_uint2(pk2(acc[ti][tj][4 * g4 + 0], acc[ti][tj][4 * g4 + 1]), pk2(acc[ti][tj][4 * g4 + 2], acc[ti][tj][4 * g4 + 3]));
    u16* dst = p.WqT() + ((size_t)lhp * 128 + wj0) * DM + kb * 128 + wi0;
#pragma unroll
    for (int it = 0; it < 8; ++it) {
      const int row = it * 8 + (lane >> 3), ch = lane & 7;
      *(u32x4*)(dst + (size_t)row * DM + ch * 8) = *(const u32x4*)(wl + row * LSTR + ch * 8);
    }
  }
}

DI void phase_proj(const Params& p, int layer, u16* lds, const int WAVE_S) {
  const int tid0 = tid_opaque();
  const int lane = tid0 & 63, wave = tid0 >> 6;
  const int r = lane & 31, h = lane >> 5;
  const int wi0 = (wave >> 1) * 64, wj0 = (wave & 1) * 64;
  if (layer == 0) fold_peer_weights(p, lds, WAVE_S);
  const u16* W = p.WinT() + (size_t)layer * 1536 * DM;
  const int xcd = blockIdx.x & 7;
  unsigned* ctr = p.bar() + (3 * 2 + layer) * 8 + xcd;
  for (;;) {
    const int slot = next_item(ctr, WAVE_S);
    if (slot >= 768) break;
    const int ft = slot % 12, tt = (slot / 12) * 8 + xcd;
    f32x16 acc[2][2];
    gemm_tile<2, 2>(W + (size_t)ft * 128 * DM, p.hb() + (size_t)tt * 128 * DM, acc, lds, wi0, wj0, WAVE_S);
    const int hit = wave >> 1;
    int type, grp, head;
    if (ft < 4) { type = 0; grp = 0; head = ft * 2 + hit; }
    else if (ft == 4) { type = 1; grp = 0; head = hit; }
    else if (ft == 5) { type = 2; grp = 0; head = hit; }
    else if (ft < 10) { type = 0; grp = 1; head = (ft - 6) * 2 + hit; }
    else if (ft == 10) { type = 1; grp = 1; head = hit; }
    else { type = 2; grp = 1; head = hit; }
    __syncthreads();
    u16* wl = lds + wave * 64 * LSTR;
#pragma unroll
    for (int tj = 0; tj < 2; ++tj) {
      const int token = tt * 128 + wj0 + tj * 32 + r;
      const int s = token & 2047;
      if (type == 2) {
#pragma unroll
        for (int ti = 0; ti < 2; ++ti)
#pragma unroll
          for (int i = 0; i < 16; ++i) {
            const int d = ti * 32 + (i & 3) + 8 * (i >> 2) + 4 * h;
            wl[d * LSTR + swz16(tj * 32 + r)] = f2bf(acc[ti][tj][i]);
          }
      } else {
        float v[2][16];
        if (grp == 0) {
          float ss = 0.f;
#pragma unroll
          for (int ti = 0; ti < 2; ++ti)
#pragma unroll
            for (int i = 0; i < 16; ++i) ss += acc[ti][tj][i] * acc[ti][tj][i];
          ss += xhalf(ss);
          const float rs = rsqrtf(ss * (1.f / 64.f) + 1e-6f);
          const float* gw = (type == 0 ? p.qn_g : p.kn_g) + layer * 64;
#pragma unroll
          for (int ti = 0; ti < 2; ++ti)
#pragma unroll
            for (int g4 = 0; g4 < 4; ++g4) {
              const float4 gg = *(const float4*)(gw + ti * 32 + 8 * g4 + 4 * h);
              v[ti][4 * g4 + 0] = acc[ti][tj][4 * g4 + 0] * rs * gg.x;
              v[ti][4 * g4 + 1] = acc[ti][tj][4 * g4 + 1] * rs * gg.y;
              v[ti][4 * g4 + 2] = acc[ti][tj][4 * g4 + 2] * rs * gg.z;
              v[ti][4 * g4 + 3] = acc[ti][tj][4 * g4 + 3] * rs * gg.w;
            }
#pragma unroll
          for (int ti = 0; ti < 2; ++ti)
#pragma unroll
            for (int g4 = 0; g4 < 2; ++g4) {
              const float4 cc = *(const float4*)(p.rope() + (s * 2 + ti) * 16 + 8 * g4 + 4 * h);
              const float4 sn = *(const float4*)(p.rope() + SEQ * 32 + (s * 2 + ti) * 16 + 8 * g4 + 4 * h);
              const float c4[4] = {cc.x, cc.y, cc.z, cc.w};
              const float s4[4] = {sn.x, sn.y, sn.z, sn.w};
#pragma unroll
              for (int jj = 0; jj < 4; ++jj) {
                const float x1 = v[ti][4 * g4 + jj], x2 = v[ti][4 * g4 + jj + 8];
                v[ti][4 * g4 + jj] = x1 * c4[jj] - x2 * s4[jj];
                v[ti][4 * g4 + jj + 8] = x1 * s4[jj] + x2 * c4[jj];
              }
            }
        } else {
#pragma unroll
          for (int ti = 0; ti < 2; ++ti)
#pragma unroll
            for (int i = 0; i < 16; ++i) v[ti][i] = acc[ti][tj][i];
        }
        const float sc = (type == 0) ? QSCALE : 1.0f;
#pragma unroll
        for (int ti = 0; ti < 2; ++ti)
#pragma unroll
          for (int g4 = 0; g4 < 4; ++g4)
            *(uint2*)(wl + (tj * 32 + r) * LSTR + ti * 32 + 8 * g4 + 4 * h) =
                make_uint2(pk2(v[ti][4 * g4 + 0] * sc, v[ti][4 * g4 + 1] * sc), pk2(v[ti][4 * g4 + 2] * sc, v[ti][4 * g4 + 3] * sc));
      }
    }
    {
      const int token0 = tt * 128 + wj0;
      const int b = token0 >> 11, s0 = token0 & 2047;
      u16* dst;
      size_t rstride;
      if (type == 2) { dst = p.vtbuf() + ((size_t)(grp * 32 + b) * 2 + head) * 64 * SEQ + s0; rstride = SEQ; }
      else if (type == 0) { dst = p.qbuf() + (((size_t)(grp * 32 + b) * 8 + head) * SEQ + s0) * 64; rstride = 64; }
      else { dst = p.kbuf() + (((size_t)(grp * 32 + b) * 2 + head) * SEQ + s0) * 64; rstride = 64; }
#pragma unroll
      for (int it = 0; it < 8; ++it) {
        const int row = it * 8 + (lane >> 3), ch = lane & 7;
        *(u32x4*)(dst + (size_t)row * rstride + ch * 8) = *(const u32x4*)(wl + row * LSTR + ch * 8);
      }
    }
  }
}

template <int MODE>
DI void attn_item(const Params& p, int layer, int b, int hq, int qb, u16* lds, const int WAVE_S) {
  const int tid = tid_opaque(), lane = tid & 63, wave = tid >> 6;
  const int r = lane & 31, h = lane >> 5;
  const int kvh = hq >> 2;
  const int q0 = qb * 128 + wave * 32;
  const u16* qp = p.qbuf() + (((size_t)(MODE * 32 + b) * 8 + hq) * SEQ + q0 + r) * 64;
  const u16* kp = p.kbuf() + ((size_t)(MODE * 32 + b) * 2 + kvh) * SEQ * 64;
  const u16* vp = p.vtbuf() + ((size_t)(MODE * 32 + b) * 2 + kvh) * 64 * SEQ;
  bf16x8 qf[4];
#pragma unroll
  for (int ks = 0; ks < 4; ++ks) qf[ks] = *(const bf16x8*)(qp + ks * 16 + h * 8);
  int t_begin, t_end, kbase0;
  if (MODE == 0) { t_begin = 0; t_end = 32; kbase0 = 0; }
  else { t_begin = (qb == 0) ? 2 : 0; t_end = (qb == 15) ? 4 : 6; kbase0 = qb * 128 - 128; }
  float m_run, l_run;
  float slope2 = 0.f;
  if (MODE == 0) { m_run = 0.f; l_run = 0.f; }
  else {
    m_run = p.sink[layer * 8 + hq] * LOG2E;
    l_run = (h == 0) ? 1.f : 0.f;
    slope2 = exp2f(-(float)(hq + 1)) * LOG2E;
  }
  f32x16 negm;
#pragma unroll
  for (int i = 0; i < 16; ++i) negm[i] = -m_run;
  f32x16 o[2];
#pragma unroll
  for (int dt = 0; dt < 2; ++dt)
#pragma unroll
    for (int i = 0; i < 16; ++i) o[dt][i] = 0.f;
  const int lr = tid >> 3, lc = (tid & 7) * 8;
  u32x4 kr[2], vr[2];
  {
    const int kb = kbase0 + t_begin * 64;
#pragma unroll
    for (int it = 0; it < 2; ++it) {
      kr[it] = *(const u32x4*)(kp + (size_t)(kb + lr + 32 * it) * 64 + lc);
      vr[it] = *(const u32x4*)(vp + (size_t)(lr + 32 * it) * SEQ + kb + lc);
    }
  }
  __syncthreads();
  {
    u16* K0 = lds + (t_begin & 1) * 128 * LSTR;
#pragma unroll
    for (int it = 0; it < 2; ++it) {
      *(u32x4*)(K0 + (lr + 32 * it) * LSTR + lc) = kr[it];
      *(u32x4*)(K0 + 64 * LSTR + (lr + 32 * it) * LSTR + lc) = vr[it];
    }
    if (t_begin + 1 < t_end) {
      const int kb = kbase0 + (t_begin + 1) * 64;
#pragma unroll
      for (int it = 0; it < 2; ++it) {
        kr[it] = *(const u32x4*)(kp + (size_t)(kb + lr + 32 * it) * 64 + lc);
        vr[it] = *(const u32x4*)(vp + (size_t)(lr + 32 * it) * SEQ + kb + lc);
      }
    }
  }
  for (int t = t_begin; t < t_end; ++t) {
    __syncthreads();
    const u16* Ks = lds + (t & 1) * 128 * LSTR;
    const u16* Vs = Ks + 64 * LSTR;
    if (t + 1 < t_end) {
      u16* Kn = lds + ((t + 1) & 1) * 128 * LSTR;
#pragma unroll
      for (int it = 0; it < 2; ++it) {
        *(u32x4*)(Kn + (lr + 32 * it) * LSTR + lc) = kr[it];
        *(u32x4*)(Kn + 64 * LSTR + (lr + 32 * it) * LSTR + lc) = vr[it];
      }
      if (t + 2 < t_end) {
        const int kb = kbase0 + (t + 2) * 64;
#pragma unroll
        for (int it = 0; it < 2; ++it) {
          kr[it] = *(const u32x4*)(kp + (size_t)(kb + lr + 32 * it) * 64 + lc);
          vr[it] = *(const u32x4*)(vp + (size_t)(lr + 32 * it) * SEQ + kb + lc);
        }
      }
    }
    bool live = true;
    if (MODE == 1) {
      const int kb = kbase0 + t * 64;
      const int gap = (kb > q0 + 31) ? kb - (q0 + 31) : ((kb + 63 < q0) ? q0 - (kb + 63) : 0);
      live = gap <= 128;
    }
    if (live) {
    f32x16 sc[2];
#pragma unroll
    for (int k2 = 0; k2 < 2; ++k2) {
#pragma unroll
      for (int ks = 0; ks < 4; ++ks) {
        const bf16x8 kf = *(const bf16x8*)(Ks + (k2 * 32 + r) * LSTR + ks * 16 + h * 8);
        sc[k2] = (ks == 0) ? MFMA32(kf, qf[0], negm) : MFMA32(kf, qf[ks], sc[k2]);
      }
    }
    if (MODE == 1) {
      const float tposf = (float)(q0 + r - (kbase0 + t * 64) - 4 * h);
#pragma unroll
      for (int k2 = 0; k2 < 2; ++k2)
#pragma unroll
        for (int i = 0; i < 16; ++i) {
          const float dist = fabsf(tposf - (float)(k2 * 32 + (i & 3) + 8 * (i >> 2)));
          sc[k2][i] = (dist <= 128.f) ? (sc[k2][i] - slope2 * dist) : -1e30f;
        }
    }
    float mx0 = fmaxf(fmaxf(sc[0][0], sc[0][1]), sc[0][2]), mx1 = fmaxf(fmaxf(sc[1][0], sc[1][1]), sc[1][2]);
#pragma unroll
    for (int i = 3; i < 15; i += 2) { mx0 = fmaxf(fmaxf(mx0, sc[0][i]), sc[0][i + 1]); mx1 = fmaxf(fmaxf(mx1, sc[1][i]), sc[1][i + 1]); }
    float mx = fmaxf(fmaxf(mx0, mx1), fmaxf(sc[0][15], sc[1][15]));
    {
      auto rr = __builtin_amdgcn_permlane32_swap(__float_as_uint(mx), __float_as_uint(mx), false, false);
      mx = fmaxf(__uint_as_float(rr[0]), __uint_as_float(rr[1]));
    }
    if (__any(mx > 8.0f)) {
      const float delta = fmaxf(mx, 0.f);
      const float al = __builtin_amdgcn_exp2f(-delta);
#pragma unroll
      for (int k2 = 0; k2 < 2; ++k2)
#pragma unroll
        for (int i = 0; i < 16; ++i) sc[k2][i] -= delta;
#pragma unroll
      for (int dt = 0; dt < 2; ++dt)
#pragma unroll
        for (int i = 0; i < 16; ++i) o[dt][i] *= al;
      l_run *= al;
      m_run += delta;
#pragma unroll
      for (int i = 0; i < 16; ++i) negm[i] = -m_run;
    }
    f32x2_t ps2 = {0.f, 0.f};
#pragma unroll
    for (int k2 = 0; k2 < 2; ++k2)
#pragma unroll
      for (int i = 0; i < 16; i += 2) {
        const float e0 = __builtin_amdgcn_exp2f(sc[k2][i]), e1 = __builtin_amdgcn_exp2f(sc[k2][i + 1]);
        sc[k2][i] = e0;
        sc[k2][i + 1] = e1;
        ps2 += (f32x2_t){e0, e1};
      }
    l_run += ps2[0] + ps2[1];
    bf16x8 pf[2][2];
#pragma unroll
    for (int k2 = 0; k2 < 2; ++k2)
#pragma unroll
      for (int st = 0; st < 2; ++st) pf[k2][st] = pack8(sc[k2], st);
#pragma unroll
    for (int dt = 0; dt < 2; ++dt)
#pragma unroll
      for (int k2 = 0; k2 < 2; ++k2)
#pragma unroll
        for (int st = 0; st < 2; ++st) {
          const bf16x8 vf = *(const bf16x8*)(Vs + (dt * 32 + r) * LSTR + k2 * 32 + st * 16 + h * 8);
          o[dt] = MFMA32(vf, pf[k2][st], o[dt]);
        }
    }
  }
  const float lt = l_run + xhalf(l_run);
  const float inv = 1.f / lt;
  float ss = 0.f;
#pragma unroll
  for (int dt = 0; dt < 2; ++dt)
#pragma unroll
    for (int i = 0; i < 16; ++i) { o[dt][i] *= inv; ss += o[dt][i] * o[dt][i]; }
  ss += xhalf(ss);
  const float rs = rsqrtf(ss * (1.f / 64.f) + 1e-6f);
  const float* gn = (MODE == 0 ? p.gn_a_g : p.gn_b_g) + layer * 512 + hq * 64;
  u16* dst = p.ob() + ((size_t)b * SEQ + q0 + r) * DM + MODE * 512 + hq * 64;
#pragma unroll
  for (int dt = 0; dt < 2; ++dt)
#pragma unroll
    for (int g4 = 0; g4 < 4; ++g4) {
      const int d = dt * 32 + 8 * g4 + 4 * h;
      const float4 gg = *(const float4*)(gn + d);
      *(uint2*)(dst + d) = make_uint2(pk2(o[dt][4 * g4 + 0] * rs * gg.x, o[dt][4 * g4 + 1] * rs * gg.y),
                                      pk2(o[dt][4 * g4 + 2] * rs * gg.z, o[dt][4 * g4 + 3] * rs * gg.w));
    }
}

DI void phase_attn(const Params& p, int layer, u16* lds, const int WAVE_S) {
  const int xcd = blockIdx.x & 7;
  unsigned* ctr = p.bar() + (0 * 2 + layer) * 8 + xcd;
  for (;;) {
    const int it = next_item(ctr, WAVE_S);
    if (it >= 1024) break;
    const int mode = it >> 9, slot = it & 511;
    const int grp = (slot >> 6) * 8 + xcd;
    const int within = slot & 63;
    const int b = grp >> 1, kvh = grp & 1;
    const int hq = kvh * 4 + (within >> 4), qb = within & 15;
    if (mode == 0) attn_item<0>(p, layer, b, hq, qb, lds, WAVE_S);
    else attn_item<1>(p, layer, b, hq, qb, lds, WAVE_S);
  }
}

DI void phase_wo(const Params& p, int layer, u16* lds, const int WAVE_S) {
  const int tid0 = tid_opaque();
  const int lane = tid0 & 63, wave = tid0 >> 6;
  const int r = lane & 31, h = lane >> 5;
  const int wi0 = (wave >> 1) * 64, wj0 = (wave & 1) * 64;
  const u16* W = p.WoT() + (size_t)layer * 1024 * DM;
  const int xcd = blockIdx.x & 7;
  unsigned* ctr = p.bar() + (1 * 2 + layer) * 8 + xcd;
  for (;;) {
    const int slot = next_item(ctr, WAVE_S);
    if (slot >= 512) break;
    const int ft = slot & 7, tt = (slot >> 3) * 8 + xcd;
    f32x16 acc[2][2];
    gemm_tile<2, 2>(W + (size_t)ft * 128 * DM, p.ob() + (size_t)tt * 128 * DM, acc, lds, wi0, wj0, WAVE_S);
    __syncthreads();
    u16* wl = lds + wave * 64 * LSTR;
#pragma unroll
    for (int tj = 0; tj < 2; ++tj)
#pragma unroll
      for (int ti = 0; ti < 2; ++ti)
#pragma unroll
        for (int g4 = 0; g4 < 4; ++g4)
          *(uint2*)(wl + (tj * 32 + r) * LSTR + ti * 32 + 8 * g4 + 4 * h) =
              make_uint2(pk2(acc[ti][tj][4 * g4 + 0], acc[ti][tj][4 * g4 + 1]), pk2(acc[ti][tj][4 * g4 + 2], acc[ti][tj][4 * g4 + 3]));
    u16* dst = p.yb() + (size_t)(tt * 128 + wj0) * DM + ft * 128 + wi0;
#pragma unroll
    for (int it = 0; it < 8; ++it) {
      const int row = it * 8 + (lane >> 3), ch = lane & 7;
      *(u32x4*)(dst + (size_t)row * DM + ch * 8) = *(const u32x4*)(wl + row * LSTR + ch * 8);
    }
  }
}

DI void phase_peer_q(const Params& p, int layer, u16* lds, const int WAVE_S) {
  const int tid0 = tid_opaque();
  const int lane = tid0 & 63, wave = tid0 >> 6;
  const int r = lane & 31, h = lane >> 5;
  const u16* W = p.WqT() + (size_t)layer * 2048 * DM;
  const int xcd = blockIdx.x & 7;
  unsigned* ctr = p.bar() + (2 * 2 + layer) * 8 + xcd;
  for (;;) {
    const int slot = next_item(ctr, WAVE_S);
    if (slot >= 512) break;
    const int head = slot & 7, tt = (slot >> 3) * 8 + xcd;
    float t0[16], t[16];
#pragma unroll 1
    for (int half = 0; half < 2; ++half) {
      f32x16 acc[4][1];
      gemm_tile<4, 1>(W + (size_t)(head * 2 + half) * 128 * DM, p.hb() + (size_t)tt * 128 * DM, acc, lds, 0, wave * 32, WAVE_S);
#pragma unroll
      for (int i = 0; i < 16; ++i) t[i] = -3.0e38f;
#pragma unroll
      for (int nt = 0; nt < 4; ++nt)
#pragma unroll
        for (int i = 0; i < 16; ++i) {
          const uint32_t n = nt * 32 + (i & 3) + 8 * (i >> 2) + 4 * h;
          const float v = __uint_as_float((__float_as_uint(acc[nt][0][i]) & ~127u) | n);
          ins16n(t, v, nt * 16 + i);
        }
      float o16[16];
#pragma unroll
      for (int i = 0; i < 16; ++i) {
        auto rr = __builtin_amdgcn_permlane32_swap(__float_as_uint(t[i]), __float_as_uint(t[i]), false, false);
        o16[i] = __uint_as_float(h ? rr[0] : rr[1]);
      }
#pragma unroll
      for (int i = 0; i < 16; ++i) t[i] = fmaxf(t[i], o16[15 - i]);
#pragma unroll
      for (int st = 8; st >= 1; st >>= 1)
#pragma unroll
        for (int i = 0; i < 16; ++i)
          if ((i & st) == 0) {
            const float hi = fmaxf(t[i], t[i + st]), lo = fminf(t[i], t[i + st]);
            t[i] = hi;
            t[i + st] = lo;
          }
      if (half == 0) {
#pragma unroll
        for (int i = 0; i < 16; ++i) t0[i] = t[i];
      }
    }
    float c[16];
#pragma unroll
    for (int i = 0; i < 16; ++i) c[i] = -3.0e38f;
#pragma unroll
    for (int i = 0; i < 16; ++i)
#pragma unroll
      for (int j = 0; j < 16; ++j)
        if ((i + 1) * (j + 1) <= 16) {
          const float sv = t0[i] + t[j];
          ins16(c, __uint_as_float((__float_as_uint(sv) & ~255u) | (uint32_t)(i * 16 + j)));
        }
    __syncthreads();
    uint32_t* wl = (uint32_t*)lds + wave * (32 * 33);
    if (h == 0) {
#pragma unroll
      for (int i = 0; i < 16; ++i) { wl[r * 33 + i] = __float_as_uint(t0[i]); wl[r * 33 + 16 + i] = __float_as_uint(t[i]); }
    }
    float sv[16];
    uint32_t ev[16];
    float smax = -3.0e38f;
#pragma unroll
    for (int k = 0; k < 16; ++k) {
      const uint32_t pos = __float_as_uint(c[k]) & 255u;
      const uint32_t ai = wl[r * 33 + (pos >> 4)];
      const uint32_t bj = wl[r * 33 + 16 + (pos & 15)];
      sv[k] = __uint_as_float(ai & ~127u) + __uint_as_float(bj & ~127u);
      ev[k] = ((ai & 127u) << 7) | (bj & 127u);
      smax = fmaxf(smax, sv[k]);
    }
    float ssum = 0.f;
#pragma unroll
    for (int k = 0; k < 16; ++k) { sv[k] = __expf(sv[k] - smax); ssum += sv[k]; }
    const float rinv = 1.f / ssum;
    const int tq = tid_opaque();
    const size_t item = (size_t)(tt * 128 + (tq >> 6) * 32 + (tq & 31)) * 8 + head;
    if (((tq >> 5) & 1) == 0) {
      u32x4* de = (u32x4*)(p.sel_e() + item * 16);
#pragma unroll
      for (int g4 = 0; g4 < 2; ++g4) {
        u32x4 w;
#pragma unroll
        for (int j = 0; j < 4; ++j) w[j] = ev[8 * g4 + 2 * j] | (ev[8 * g4 + 2 * j + 1] << 16);
        de[g4] = w;
      }
    } else {
      f32x4* dg = (f32x4*)(p.sel_g() + item * 16);
#pragma unroll
      for (int g4 = 0; g4 < 4; ++g4) {
        f32x4 w = {sv[4 * g4] * rinv, sv[4 * g4 + 1] * rinv, sv[4 * g4 + 2] * rinv, sv[4 * g4 + 3] * rinv};
        dg[g4] = w;
      }
    }
  }
}

DI void phase_peer_merge(const Params& p, const int WAVE_S) {
  const int gt = blockIdx.x * 256 + tid_opaque(), gn = gridDim.x * 256;
  for (int item = gt; item < T_TOK * 8; item += gn) {
    const uint32_t* tkp = p.tk() + (size_t)item * 32;
    float a[16], bb[16];
#pragma unroll
    for (int g4 = 0; g4 < 4; ++g4) {
      const u32x4 ua = ((const u32x4*)tkp)[g4];
      const u32x4 ubv = ((const u32x4*)tkp)[4 + g4];
#pragma unroll
      for (int j = 0; j < 4; ++j) { a[4 * g4 + j] = __uint_as_float(ua[j]); bb[4 * g4 + j] = __uint_as_float(ubv[j]); }
    }
    float c[16];
#pragma unroll
    for (int i = 0; i < 16; ++i) c[i] = -3.0e38f;
#pragma unroll
    for (int i = 0; i < 16; ++i)
#pragma unroll
      for (int j = 0; j < 16; ++j)
        if ((i + 1) * (j + 1) <= 16) {
          const float sv = a[i] + bb[j];
          ins16(c, __uint_as_float((__float_as_uint(sv) & ~255u) | (uint32_t)(i * 16 + j)));
        }
    float sv[16];
    uint32_t ev[16];
    float smax = -3.0e38f;
#pragma unroll
    for (int k = 0; k < 16; ++k) {
      const uint32_t pos = __float_as_uint(c[k]) & 255u;
      const uint32_t ai = tkp[pos >> 4];
      const uint32_t bj = tkp[16 + (pos & 15)];
      sv[k] = __uint_as_float(ai & ~127u) + __uint_as_float(bj & ~127u);
      ev[k] = ((ai & 127u) << 7) | (bj & 127u);
      smax = fmaxf(smax, sv[k]);
    }
    float ssum = 0.f;
#pragma unroll
    for (int k = 0; k < 16; ++k) { sv[k] = __expf(sv[k] - smax); ssum += sv[k]; }
    const float rinv = 1.f / ssum;
    u32x4* de = (u32x4*)(p.sel_e() + (size_t)item * 16);
    f32x4* dg = (f32x4*)(p.sel_g() + (size_t)item * 16);
#pragma unroll
    for (int g4 = 0; g4 < 2; ++g4) {
      u32x4 w;
#pragma unroll
      for (int j = 0; j < 4; ++j) w[j] = ev[8 * g4 + 2 * j] | (ev[8 * g4 + 2 * j + 1] << 16);
      de[g4] = w;
    }
#pragma unroll
    for (int g4 = 0; g4 < 4; ++g4) {
      f32x4 w = {sv[4 * g4] * rinv, sv[4 * g4 + 1] * rinv, sv[4 * g4 + 2] * rinv, sv[4 * g4 + 3] * rinv};
      dg[g4] = w;
    }
  }
}

DI void phase_peer_u(const Params& p, int layer, const int WAVE_S) {
  const int tid = tid_opaque();
  const int lane = tid & 63, wave = tid >> 6;
  const int slice = blockIdx.x & 7;
  const int wv = (blockIdx.x >> 3) * 4 + wave;
  const int nwv = ((gridDim.x - slice + 7) >> 3) * 4;
  const int es = lane >> 3, c = lane & 7;
  const uint8_t* ubase = p.uq() + (size_t)(layer * 8 + slice) * NEXP * 128;
  const uint32_t coff = (uint32_t)c << 4;
  u16* part = p.partial() + (size_t)slice * T_TOK * 128;
  const bool b2 = (lane >> 2) & 1, b1 = (lane >> 1) & 1, b0 = lane & 1;
  auto load_se = [&](int token, u32x4& se0, u32x4& se1) {
    token = token < T_TOK ? token : T_TOK - 1;
    se0 = *(const u32x4*)(p.sel_e() + (size_t)token * 128 + es * 16);
    se1 = *(const u32x4*)(p.sel_e() + (size_t)token * 128 + es * 16 + 8);
  };
  auto load_x = [&](int token) -> u32x4 {
    token = token < T_TOK ? token : T_TOK - 1;
    return *(const u32x4*)(p.xq() + ((size_t)slice * T_TOK + token) * 128 + c * 16);
  };
  auto load_half = [&](const u32x4& se, u32x4 (&vv)[8]) {
#pragma unroll
    for (int it = 0; it < 8; ++it) {
      const uint32_t e = (se[it >> 1] >> (16 * (it & 1))) & 0xffffu;
      vv[it] = *(const u32x4*)(ubase + ((e << 7) | coff));
    }
  };
  auto dot_half = [&](const u32x4 (&vv)[8], const u32x4& xq, int (&ds)[8]) {
#pragma unroll
    for (int it = 0; it < 8; ++it) {
      int a = 0;
#pragma unroll
      for (int dw = 0; dw < 4; ++dw) a = __builtin_amdgcn_sdot4((int)vv[it][dw], (int)xq[dw], a, false);
      ds[it] = a;
    }
  };
  auto finish = [&](int token, const int (&lo)[8], const int (&hi)[8]) {
    int r8[8], r4[4], r2[2];
#pragma unroll
    for (int k = 0; k < 8; ++k) {
      const int send = b2 ? lo[k] : hi[k], keep = b2 ? hi[k] : lo[k];
      r8[k] = keep + shxi(send, 4, lane);
    }
#pragma unroll
    for (int k = 0; k < 4; ++k) {
      const int send = b1 ? r8[k] : r8[k + 4], keep = b1 ? r8[k + 4] : r8[k];
      r4[k] = keep + shxi(send, 2, lane);
    }
#pragma unroll
    for (int k = 0; k < 2; ++k) {
      const int send = b0 ? r4[k] : r4[k + 2], keep = b0 ? r4[k + 2] : r4[k];
      r2[k] = keep + shxi(send, 1, lane);
    }
    *(uint32_t*)(part + (size_t)token * 128 + 2 * lane) = pk2((float)r2[0], (float)r2[1]);
  };
  u32x4 vA[8], vB[8], se0c, se1c, se0n, se1n, xc, xn;
  int t = wv;
  if (t >= T_TOK) return;
  load_se(t, se0c, se1c);
  xc = load_x(t);
  load_se(t + nwv, se0n, se1n);
  load_half(se0c, vA);
  for (;;) {
    int lo[8], hi[8];
    load_half(se1c, vB);
    dot_half(vA, xc, lo);
    load_half(se0n, vA);
    xn = load_x(t + nwv);
    dot_half(vB, xc, hi);
    finish(t, lo, hi);
    se0c = se0n; se1c = se1n; xc = xn;
    load_se(t + 2 * nwv, se0n, se1n);
    t += nwv;
    if (t >= T_TOK) break;
  }
}

DI void phase_peer_w(const Params& p, int layer, const int WAVE_S) {
  const int gt = blockIdx.x * 256 + tid_opaque(), gn = gridDim.x * 256;
  const float* us = p.uscale() + layer * NEXP;
  const float* vs = p.vscale() + layer * NEXP;
  for (int i4 = gt; i4 < T_TOK * 32; i4 += gn) {
    f32x4 sum = {0.f, 0.f, 0.f, 0.f};
#pragma unroll
    for (int sl = 0; sl < 8; ++sl) {
      const uint2 pv = ((const uint2*)(p.partial() + (size_t)sl * T_TOK * 128))[i4];
      sum += (f32x4){bflo(pv.x), bfhi(pv.x), bflo(pv.y), bfhi(pv.y)};
    }
    const uint2 ep = ((const uint2*)p.sel_e())[i4];
    const float xs = p.xscale()[i4 >> 5];
    const f32x4 gg = ((const f32x4*)p.sel_g())[i4];
    const uint32_t e[4] = {ep.x & 0xffffu, ep.x >> 16, ep.y & 0xffffu, ep.y >> 16};
    f32x4 w;
#pragma unroll
    for (int j = 0; j < 4; ++j) {
      const float a = sum[j] * us[e[j]] * xs;
      const float ge = 0.5f * a * (1.f + erff(a * 0.70710678118f));
      w[j] = gg[j] * ge * vs[e[j]];
    }
    ((f32x4*)p.wbuf())[i4] = w;
  }
}

DI void phase_peer_v(const Params& p, int layer, const int WAVE_S) {
  const int tid = tid_opaque();
  const int lane = tid & 63, wave = tid >> 6;
  const int slice = blockIdx.x & 7;
  const int wv = (blockIdx.x >> 3) * 4 + wave;
  const int nwv = ((gridDim.x - slice + 7) >> 3) * 4;
  const int es = lane >> 3, c = lane & 7;
  const uint8_t* vbase = p.vq() + (size_t)(layer * 8 + slice) * NEXP * 128;
  const uint32_t coff = (uint32_t)c << 4;
  const bool b5 = (lane >> 5) & 1, b4 = (lane >> 4) & 1, b3 = (lane >> 3) & 1;
  const int dl = 16 * c + 8 * (int)b5 + 4 * (int)b4 + 2 * (int)b3;
  auto load_se = [&](int token, u32x4& se0, u32x4& se1) {
    token = token < T_TOK ? token : T_TOK - 1;
    se0 = *(const u32x4*)(p.sel_e() + (size_t)token * 128 + es * 16);
    se1 = *(const u32x4*)(p.sel_e() + (size_t)token * 128 + es * 16 + 8);
  };
  auto load_w = [&](int token, f32x4 (&wv4)[4]) {
    token = token < T_TOK ? token : T_TOK - 1;
#pragma unroll
    for (int i = 0; i < 4; ++i) wv4[i] = *(const f32x4*)(p.wbuf() + (size_t)token * 128 + es * 16 + 4 * i);
  };
  auto load_half = [&](const u32x4& se, u32x4 (&vv)[8]) {
#pragma unroll
    for (int it = 0; it < 8; ++it) {
      const uint32_t e = (se[it >> 1] >> (16 * (it & 1))) & 0xffffu;
      vv[it] = *(const u32x4*)(vbase + ((e << 7) | coff));
    }
  };
  auto axpy_half = [&](const u32x4 (&vv)[8], const f32x4& w0, const f32x4& w1, f32x2_t (&acc)[8]) {
#pragma unroll
    for (int it = 0; it < 8; ++it) {
      const float w = (it < 4) ? w0[it & 3] : w1[it & 3];
      const f32x2_t w2 = {w, w};
#pragma unroll
      for (int dw = 0; dw < 4; ++dw) {
        const f32x2_t lo = __builtin_amdgcn_cvt_pk_f32_fp8((int)vv[it][dw], false);
        const f32x2_t hi = __builtin_amdgcn_cvt_pk_f32_fp8((int)vv[it][dw], true);
        acc[2 * dw] = __builtin_elementwise_fma(lo, w2, acc[2 * dw]);
        acc[2 * dw + 1] = __builtin_elementwise_fma(hi, w2, acc[2 * dw + 1]);
      }
    }
  };
  auto finish = [&](int token, const f32x2_t (&acc)[8]) {
    float r8[8], r4[4], r2[2];
#pragma unroll
    for (int k = 0; k < 8; ++k) {
      auto rr = __builtin_amdgcn_permlane32_swap(__float_as_uint(acc[k >> 1][k & 1]), __float_as_uint(acc[4 + (k >> 1)][k & 1]), false, false);
      r8[k] = __uint_as_float(rr[0]) + __uint_as_float(rr[1]);
    }
#pragma unroll
    for (int k = 0; k < 4; ++k) {
      auto rr = __builtin_amdgcn_permlane16_swap(__float_as_uint(r8[k]), __float_as_uint(r8[k + 4]), false, false);
      r4[k] = __uint_as_float(rr[0]) + __uint_as_float(rr[1]);
    }
#pragma unroll
    for (int k = 0; k < 2; ++k) {
      const float send = b3 ? r4[k] : r4[k + 2], keep = b3 ? r4[k + 2] : r4[k];
      r2[k] = keep + shx(send, 8, lane);
    }
    *(uint32_t*)(p.yb() + (size_t)token * DM + slice * 128 + dl) = pk2(r2[0], r2[1]);
  };
  u32x4 vA[8], vB[8], se0c, se1c, se0n, se1n;
  f32x4 wc[4], wn[4];
  int t = wv;
  if (t >= T_TOK) return;
  load_se(t, se0c, se1c);
  load_w(t, wc);
  load_se(t + nwv, se0n, se1n);
  load_half(se0c, vA);
  for (;;) {
    f32x2_t acc[8];
#pragma unroll
    for (int k = 0; k < 8; ++k) acc[k] = (f32x2_t){0.f, 0.f};
    load_half(se1c, vB);
    axpy_half(vA, wc[0], wc[1], acc);
    load_half(se0n, vA);
    load_w(t + nwv, wn);
    axpy_half(vB, wc[2], wc[3], acc);
    finish(t, acc);
    se0c = se0n; se1c = se1n;
#pragma unroll
    for (int i = 0; i < 4; ++i) wc[i] = wn[i];
    load_se(t + 2 * nwv, se0n, se1n);
    t += nwv;
    if (t >= T_TOK) break;
  }
}

#define XB_TMO      128
#define XB_XCNT(j)  (256  + 64 * (j))
#define XB_XSUB(j)  (1280 + 64 * (j))
#define XB_XGEN(j)  (2304 + 64 * (j))
#define XB_TOP      3328
#define XB_TOPGEN   3392
#define XCD_BAR_WORDS 3456
#define XB_SPIN_CAP (1u << 20)
#define LAS __attribute__((address_space(3)))
DI unsigned xb_ld(unsigned* p) { return __hip_atomic_load(p, __ATOMIC_RELAXED, __HIP_MEMORY_SCOPE_AGENT); }
DI unsigned xb_add(unsigned* p, unsigned v) { return __hip_atomic_fetch_add(p, v, __ATOMIC_RELAXED, __HIP_MEMORY_SCOPE_AGENT); }
DI unsigned xb_xcc_id() { return (unsigned)__builtin_amdgcn_s_getreg((3 << 11) | 20) & 0xFu; }
#define XB_SPIN(cond, bar) do { unsigned _sp = 0; while (cond) { __builtin_amdgcn_s_sleep(1); \
    if ((++_sp & 255u) == 0u) { if (xb_ld(&(bar)[XB_TMO])) break; if (_sp > XB_SPIN_CAP) { atomicAdd(&(bar)[XB_TMO], 1u); break; } } } } while (0)
struct XcdBarrier { unsigned* bar; unsigned x; volatile LAS unsigned* st; };
DI XcdBarrier xcd_barrier_post(unsigned* bar, volatile LAS unsigned* st, const int WAVE_S) {
  XcdBarrier b; b.bar = bar; b.x = xb_xcc_id(); b.st = st;
  if (tid_opaque() == 0) (void)xb_add(&bar[XB_XCNT(b.x)], 1u);
  return b;
}
DI void xcd_barrier_complete(unsigned* bar, unsigned x, unsigned& nloc, unsigned& nx) {
  const unsigned G = gridDim.x * gridDim.y * gridDim.z;
  unsigned sum, cnt, mine, sp = 0u;
  for (;;) {
    sum = 0u; cnt = 0u; mine = 0u;
#pragma unroll
    for (unsigned j = 0; j < 16; ++j) { const unsigned c = xb_ld(&bar[XB_XCNT(j)]); sum += c; cnt += (c > 0u) ? 1u : 0u; mine = (j == x) ? c : mine; }
    if (sum == G) break;
    __builtin_amdgcn_s_sleep(1);
    if ((++sp & 255u) == 0u) { if (xb_ld(&bar[XB_TMO])) break; if (sp > XB_SPIN_CAP) { atomicAdd(&bar[XB_TMO], 1u); break; } }
  }
  nloc = mine > 0u ? mine : 1u; nx = cnt > 0u ? cnt : 1u;
}
DI void xcd_barrier(const XcdBarrier& b, const int WAVE_S) {
  asm volatile("s_waitcnt vmcnt(0)" ::: "memory");
  __syncthreads();
  if (tid_opaque() == 0) {
    unsigned* bar = b.bar;
    __builtin_amdgcn_s_waitcnt(0);
    unsigned nloc = b.st[0], nx = b.st[1];
    if (nloc == 0u) { xcd_barrier_complete(bar, b.x, nloc, nx); b.st[0] = nloc; b.st[1] = nx; }
    const unsigned old = xb_add(&bar[XB_XSUB(b.x)], 1u);
    const unsigned gen = old / nloc;
    if (old + 1u == (gen + 1u) * nloc) {
      __builtin_amdgcn_fence(__ATOMIC_RELEASE, "agent");
      asm volatile("s_waitcnt vmcnt(0)" ::: "memory");
      const unsigned og = xb_add(&bar[XB_TOP], 1u);
      const unsigned tg = og / nx;
      if (og + 1u == (tg + 1u) * nx) xb_add(&bar[XB_TOPGEN], 1u);
      else XB_SPIN(xb_ld(&bar[XB_TOPGEN]) == tg, bar);
      __builtin_amdgcn_fence(__ATOMIC_ACQUIRE, "agent");
      xb_add(&bar[XB_XGEN(b.x)], 1u);
      asm volatile("s_waitcnt vmcnt(0)" ::: "memory");
    } else {
      XB_SPIN(xb_ld(&bar[XB_XGEN(b.x)]) == gen, bar);
      __builtin_amdgcn_fence(__ATOMIC_ACQUIRE, "agent");
      asm volatile("s_waitcnt vmcnt(0)" ::: "memory");
    }
  }
  __syncthreads();
}

__global__ void __launch_bounds__(256, 3) mega_kernel(Params p) {
  __shared__ __attribute__((aligned(16))) char lds[40960];
  __shared__ uint4 xb_words;
  cg::grid_group grid = cg::this_grid();
  const int WAVE_S = __builtin_amdgcn_readfirstlane((int)(threadIdx.x >> 6));
  if (tid_opaque() == 0) xb_words = make_uint4(0u, 0u, 0u, 0u);
  __syncthreads();
  const XcdBarrier xb = xcd_barrier_post(p.bar(), (volatile LAS unsigned*)&xb_words, WAVE_S);
  prologue(p, (float*)lds, WAVE_S);
  grid.sync();
  for (int layer = 0; layer < NLAYER; ++layer) {
    phase_proj(p, layer, (u16*)lds, WAVE_S);
    xcd_barrier(xb, WAVE_S);
    phase_attn(p, layer, (u16*)lds, WAVE_S);
    xcd_barrier(xb, WAVE_S);
    phase_wo(p, layer, (u16*)lds, WAVE_S);
    xcd_barrier(xb, WAVE_S);
    ln_rows<1, true, false>(p.yb(), p.hb(), p.hb(), (uint32_t*)p.xq(), p.xscale(), nullptr, p.ln1_g + layer * DM, p.ln1_b + layer * DM, T_TOK, WAVE_S);
    xcd_barrier(xb, WAVE_S);
    phase_peer_q(p, layer, (u16*)lds, WAVE_S);
    xcd_barrier(xb, WAVE_S);
    phase_peer_u(p, layer, WAVE_S);
    xcd_barrier(xb, WAVE_S);
    phase_peer_w(p, layer, WAVE_S);
    xcd_barrier(xb, WAVE_S);
    phase_peer_v(p, layer, WAVE_S);
    xcd_barrier(xb, WAVE_S);
    ln_rows<1, false, true>(p.yb(), p.hb(), layer == NLAYER - 1 ? nullptr : p.hb(), nullptr, nullptr, layer == NLAYER - 1 ? p.out : nullptr, p.ln2_g + layer * DM, p.ln2_b + layer * DM, T_TOK, WAVE_S);
    xcd_barrier(xb, WAVE_S);
  }
}

extern "C" void kernel_launch(void* const* d_in, const int* in_sizes, int n_in, void* d_out, int out_size, void* d_ws,
                              size_t ws_size, hipStream_t stream) {
  static int grid_blocks = 0;
  if (!grid_blocks) {
    int dev = 0, cus = 0, per_cu = 0;
    hipGetDevice(&dev);
    hipDeviceGetAttribute(&cus, hipDeviceAttributeMultiprocessorCount, dev);
    hipOccupancyMaxActiveBlocksPerMultiprocessor(&per_cu, mega_kernel, 256, 0);
    if (per_cu < 1) per_cu = 1;
    if (per_cu > 3) per_cu = 3;
    grid_blocks = cus * per_cu;
  }
  Params p{};
  const float* const* in = (const float* const*)d_in;
  p.x = in[0]; p.ln_in_g = in[1]; p.ln_in_b = in[2]; p.w_in = in[3]; p.qn_g = in[4]; p.kn_g = in[5]; p.sink = in[6];
  p.gn_a_g = in[7]; p.gn_b_g = in[8]; p.w_o = in[9]; p.ln1_g = in[10]; p.ln1_b = in[11]; p.peer_wq = in[12];
  p.peer_keys = in[13]; p.peer_u = in[14]; p.peer_v = in[15]; p.ln2_g = in[16]; p.ln2_b = in[17];
  p.out = (float*)d_out;
  p.ws = (char*)d_ws;
  if (WS_TOTAL > ws_size) fprintf(stderr, "workspace too small: need %zu have %zu\n", (size_t)WS_TOTAL, ws_size);
  (void)hipMemsetAsync((char*)d_ws + OFF_bar, 0, (size_t)XCD_BAR_WORDS * 4, stream);
  void* args[] = {&p};
  hipError_t e = hipLaunchCooperativeKernel((void*)mega_kernel, dim3(grid_blocks), dim3(256), args, 0, stream);
  if (e != hipSuccess) fprintf(stderr, "cooperative launch failed: %s (grid %d)\n", hipGetErrorString(e), grid_blocks);
}
```

```cpp
#include <hip/hip_runtime.h>
#include <hip/hip_cooperative_groups.h>
#include <stdint.h>
#include <cstdio>
namespace cg = cooperative_groups;

typedef unsigned short u16;
typedef __attribute__((ext_vector_type(8))) short bf16x8;
typedef __attribute__((ext_vector_type(4))) float f32x4;
typedef __attribute__((ext_vector_type(16))) float f32x16;
typedef float f32x2_t __attribute__((ext_vector_type(2)));
typedef uint32_t u32x4 __attribute__((ext_vector_type(4)));
typedef __bf16 bf16x2_t __attribute__((ext_vector_type(2)));

#define DI __device__ __forceinline__
#define MFMA32(a, b, c) __builtin_amdgcn_mfma_f32_32x32x16_bf16((a), (b), (c), 0, 0, 0)
#define MFMA16(a, b, c) __builtin_amdgcn_mfma_f32_16x16x32_bf16((a), (b), (c), 0, 0, 0)

constexpr int T_TOK = 65536;
constexpr int DM = 1024;
constexpr int SEQ = 2048;
constexpr int NLAYER = 2;
constexpr int LSTR = 72;
constexpr float ALPHA = 1.41421356237f;
constexpr float LOG2E = 1.44269504089f;
constexpr float QSCALE = 0.125f * LOG2E;
constexpr int NEXP = 16384;

constexpr size_t al256(size_t x) { return (x + 255) & ~(size_t)255; }
constexpr size_t OFF_hb = 0;
constexpr size_t OFF_qbuf = OFF_hb + al256((size_t)T_TOK * DM * 2);
constexpr size_t OFF_kbuf = OFF_qbuf + al256((size_t)2 * T_TOK * 8 * 64 * 2);
constexpr size_t OFF_vtbuf = OFF_kbuf + al256((size_t)2 * T_TOK * 2 * 64 * 2);
constexpr size_t OFF_ob = OFF_vtbuf + al256((size_t)2 * T_TOK * 2 * 64 * 2);
constexpr size_t OFF_yb = OFF_ob + al256((size_t)T_TOK * DM * 2);
constexpr size_t OFF_tk = OFF_yb + al256((size_t)T_TOK * DM * 2);
constexpr size_t OFF_uq = OFF_tk + al256((size_t)T_TOK * 16 * 16 * 4);
constexpr size_t OFF_vq = OFF_uq + al256((size_t)NLAYER * NEXP * DM);
constexpr size_t OFF_uscale = OFF_vq + al256((size_t)NLAYER * NEXP * DM);
constexpr size_t OFF_vscale = OFF_uscale + al256((size_t)NLAYER * NEXP * 4);
constexpr size_t OFF_xq = OFF_vscale + al256((size_t)NLAYER * NEXP * 4);
constexpr size_t OFF_xscale = OFF_xq + al256((size_t)T_TOK * DM);
constexpr size_t OFF_sel_e = OFF_xscale + al256((size_t)T_TOK * 4);
constexpr size_t OFF_sel_g = OFF_sel_e + al256((size_t)T_TOK * 128 * 2);
constexpr size_t OFF_WinT = OFF_sel_g + al256((size_t)T_TOK * 128 * 4);
constexpr size_t OFF_WoT = OFF_WinT + al256((size_t)NLAYER * 1536 * DM * 2);
constexpr size_t OFF_WqT = OFF_WoT + al256((size_t)NLAYER * 1024 * DM * 2);
constexpr size_t OFF_keysP = OFF_WqT + al256((size_t)NLAYER * 2048 * DM * 2);
constexpr size_t OFF_wqP = OFF_keysP + al256((size_t)NLAYER * 8 * 2 * 128 * 128 * 2);
constexpr size_t OFF_rope = OFF_wqP + al256((size_t)NLAYER * 2048 * DM * 2);
constexpr size_t OFF_bar = OFF_rope + al256((size_t)SEQ * 32 * 2 * 4);
constexpr size_t WS_TOTAL = OFF_bar + al256((size_t)3456 * 4);

struct Params {
  const float *x, *ln_in_g, *ln_in_b, *w_in, *qn_g, *kn_g, *sink, *gn_a_g, *gn_b_g, *w_o, *ln1_g, *ln1_b,
      *peer_wq, *peer_keys, *peer_u, *peer_v, *ln2_g, *ln2_b;
  float* out;
  char* ws;
  DI u16* hb() const { return (u16*)(ws + OFF_hb); }
  DI u16* qbuf() const { return (u16*)(ws + OFF_qbuf); }
  DI u16* kbuf() const { return (u16*)(ws + OFF_kbuf); }
  DI u16* vtbuf() const { return (u16*)(ws + OFF_vtbuf); }
  DI u16* ob() const { return (u16*)(ws + OFF_ob); }
  DI u16* yb() const { return (u16*)(ws + OFF_yb); }
  DI uint32_t* tk() const { return (uint32_t*)(ws + OFF_tk); }
  DI uint8_t* uq() const { return (uint8_t*)(ws + OFF_uq); }
  DI uint8_t* vq() const { return (uint8_t*)(ws + OFF_vq); }
  DI float* uscale() const { return (float*)(ws + OFF_uscale); }
  DI float* vscale() const { return (float*)(ws + OFF_vscale); }
  DI uint8_t* xq() const { return (uint8_t*)(ws + OFF_xq); }
  DI float* xscale() const { return (float*)(ws + OFF_xscale); }
  DI u16* sel_e() const { return (u16*)(ws + OFF_sel_e); }
  DI float* sel_g() const { return (float*)(ws + OFF_sel_g); }
  DI u16* WinT() const { return (u16*)(ws + OFF_WinT); }
  DI u16* WoT() const { return (u16*)(ws + OFF_WoT); }
  DI u16* WqT() const { return (u16*)(ws + OFF_WqT); }
  DI u16* keysP() const { return (u16*)(ws + OFF_keysP); }
  DI u16* wqP() const { return (u16*)(ws + OFF_wqP); }
  DI float* rope() const { return (float*)(ws + OFF_rope); }
  DI unsigned* bar() const { return (unsigned*)(ws + OFF_bar); }
  DI u16* partial() const { return (u16*)(ws + OFF_qbuf); }
  DI float* wbuf() const { return (float*)(ws + OFF_tk); }
};

DI uint32_t pk2(float lo, float hi) {
  f32x2_t v = {lo, hi};
  bf16x2_t b = __builtin_convertvector(v, bf16x2_t);
  return __builtin_bit_cast(uint32_t, b);
}
DI u16 f2bf(float x) { return (u16)(pk2(x, 0.f) & 0xffffu); }
DI int tid_from(int wave_s) {
  int lane;
  asm volatile("v_mbcnt_lo_u32_b32 %0, -1, 0\n\tv_mbcnt_hi_u32_b32 %0, -1, %0" : "=v"(lane));
  return wave_s * 64 + lane;
}
#define tid_opaque() tid_from(WAVE_S)
DI float bflo(uint32_t u) { return __uint_as_float(u << 16); }
DI float bfhi(uint32_t u) { return __uint_as_float(u & 0xffff0000u); }
DI int lane_opaque() { int l; asm volatile("v_mbcnt_lo_u32_b32 %0, -1, 0\n\tv_mbcnt_hi_u32_b32 %0, -1, %0" : "=v"(l)); return l; }
DI float shx(float v, int m, int lane) { return __int_as_float(__builtin_amdgcn_ds_bpermute((lane ^ m) << 2, __float_as_int(v))); }
DI int shxi(int v, int m, int lane) { return __builtin_amdgcn_ds_bpermute((lane ^ m) << 2, v); }
DI float wave_sum(float v) {
  const int ln = lane_opaque();
#pragma unroll
  for (int o = 32; o > 0; o >>= 1) v += shx(v, o, ln);
  return v;
}
DI float xhalf(float v) { return shx(v, 32, lane_opaque()); }
DI int swz16(int s) { return (s & ~12) | ((s & 4) << 1) | ((s & 8) >> 1); }
DI bf16x8 pack8(const f32x16& x, int s) {
  uint4 p;
  p.x = pk2(x[8 * s + 0], x[8 * s + 1]);
  p.y = pk2(x[8 * s + 2], x[8 * s + 3]);
  p.z = pk2(x[8 * s + 4], x[8 * s + 5]);
  p.w = pk2(x[8 * s + 6], x[8 * s + 7]);
  return __builtin_bit_cast(bf16x8, p);
}
DI uint32_t pk4_fp8(float a, float b, float c, float d) {
  int r = __builtin_amdgcn_cvt_pk_fp8_f32(a, b, 0, false);
  r = __builtin_amdgcn_cvt_pk_fp8_f32(c, d, r, true);
  return (uint32_t)r;
}
DI uint32_t pk4_i8(float a, float b, float c, float d) {
  const int i0 = __float2int_rn(a), i1 = __float2int_rn(b), i2 = __float2int_rn(c), i3 = __float2int_rn(d);
  return (uint32_t)(i0 & 0xff) | ((uint32_t)(i1 & 0xff) << 8) | ((uint32_t)(i2 & 0xff) << 16) | ((uint32_t)i3 << 24);
}
DI void ins16(float (&t)[16], float x) {
#pragma unroll
  for (int i = 15; i >= 1; --i) t[i] = __builtin_amdgcn_fmed3f(t[i - 1], t[i], x);
  t[0] = fmaxf(t[0], x);
}
DI void ins16n(float (&t)[16], float x, int nf) {
#pragma unroll
  for (int i = 15; i >= 1; --i)
    if (i <= nf) t[i] = __builtin_amdgcn_fmed3f(t[i - 1], t[i], x);
  t[0] = fmaxf(t[0], x);
}

template <int SRC, bool Q8, bool OUTF>
DI void ln_rows(const void* __restrict__ srcv, const u16* res, u16* dstb, uint32_t* __restrict__ dstq, float* __restrict__ xsc, float* __restrict__ dstf,
                const float* __restrict__ g, const float* __restrict__ b, int nrows, const int WAVE_S) {
  const int tid = tid_opaque();
  const int lane = tid & 63;
  const int gw = (blockIdx.x * 256 + tid) >> 6;
  const int nw = gridDim.x * 4;
  f32x4 g4[4], b4[4];
#pragma unroll
  for (int i = 0; i < 2; ++i)
#pragma unroll
    for (int hh = 0; hh < 2; ++hh) {
      g4[2 * i + hh] = *(const f32x4*)(g + 512 * i + 8 * lane + 4 * hh);
      b4[2 * i + hh] = *(const f32x4*)(b + 512 * i + 8 * lane + 4 * hh);
    }
  constexpr int NR = (SRC == 0) ? 4 : 2;
  auto load = [&](int row, u32x4 (&sa)[NR], u32x4 (&ra)[2]) {
    row = row < nrows ? row : nrows - 1;
    if (SRC == 0) {
      const float* sp = (const float*)srcv + (size_t)row * DM + 8 * lane;
#pragma unroll
      for (int i = 0; i < 2; ++i) { sa[2 * i] = *(const u32x4*)(sp + 512 * i); sa[2 * i + 1] = *(const u32x4*)(sp + 512 * i + 4); }
    } else {
      const u16* sp = (const u16*)srcv + (size_t)row * DM + 8 * lane;
      const u16* rp = res + (size_t)row * DM + 8 * lane;
#pragma unroll
      for (int i = 0; i < 2; ++i) { sa[i] = *(const u32x4*)(sp + 512 * i); ra[i] = *(const u32x4*)(rp + 512 * i); }
    }
  };
  auto process = [&](int row, const u32x4 (&sa)[NR], const u32x4 (&ra)[2]) {
    f32x4 v[4];
    if (SRC == 0) {
#pragma unroll
      for (int q = 0; q < 4; ++q) v[q] = __builtin_bit_cast(f32x4, sa[q]);
    } else {
#pragma unroll
      for (int i = 0; i < 2; ++i)
#pragma unroll
        for (int hh = 0; hh < 2; ++hh) {
          const uint32_t s0 = sa[i][2 * hh], s1 = sa[i][2 * hh + 1], r0 = ra[i][2 * hh], r1 = ra[i][2 * hh + 1];
          v[2 * i + hh] = (f32x4){ALPHA * bflo(r0) + bflo(s0), ALPHA * bfhi(r0) + bfhi(s0), ALPHA * bflo(r1) + bflo(s1), ALPHA * bfhi(r1) + bfhi(s1)};
        }
    }
    float sum = 0.f;
#pragma unroll
    for (int q = 0; q < 4; ++q) sum += v[q][0] + v[q][1] + v[q][2] + v[q][3];
    const float mu = wave_sum(sum) * (1.f / DM);
    float sq = 0.f;
#pragma unroll
    for (int q = 0; q < 4; ++q) {
      v[q] -= mu;
      sq += v[q][0] * v[q][0] + v[q][1] * v[q][1] + v[q][2] * v[q][2] + v[q][3] * v[q][3];
    }
    const float rstd = rsqrtf(wave_sum(sq) * (1.f / DM) + 1e-5f);
    float am = 0.f;
#pragma unroll
    for (int q = 0; q < 4; ++q) {
      v[q] = v[q] * rstd * g4[q] + b4[q];
      if (Q8) am = fmaxf(am, fmaxf(fmaxf(fabsf(v[q][0]), fabsf(v[q][1])), fmaxf(fabsf(v[q][2]), fabsf(v[q][3]))));
    }
#pragma unroll
    for (int i = 0; i < 2; ++i) {
      u32x4 w = {pk2(v[2 * i][0], v[2 * i][1]), pk2(v[2 * i][2], v[2 * i][3]), pk2(v[2 * i + 1][0], v[2 * i + 1][1]), pk2(v[2 * i + 1][2], v[2 * i + 1][3])};
      if (dstb != nullptr) *(u32x4*)(dstb + (size_t)row * DM + 512 * i + 8 * lane) = w;
    }
    if (OUTF) {
      if (dstf != nullptr) {
#pragma unroll
        for (int q = 0; q < 4; ++q) *(f32x4*)(dstf + (size_t)row * DM + 512 * (q >> 1) + 8 * lane + 4 * (q & 1)) = v[q];
      }
    }
    if (Q8) {
#pragma unroll
      for (int o = 32; o > 0; o >>= 1) am = fmaxf(am, shx(am, o, lane));
      am = fmaxf(am, 1e-20f);
      const float inv = 127.f / am;
#pragma unroll
      for (int i = 0; i < 2; ++i) {
        const int sl = 4 * i + (lane >> 4);
        uint2 w = make_uint2(pk4_i8(v[2 * i][0] * inv, v[2 * i][1] * inv, v[2 * i][2] * inv, v[2 * i][3] * inv),
                             pk4_i8(v[2 * i + 1][0] * inv, v[2 * i + 1][1] * inv, v[2 * i + 1][2] * inv, v[2 * i + 1][3] * inv));
        *(uint2*)((char*)dstq + ((size_t)sl * T_TOK + row) * 128 + (lane & 15) * 8) = w;
      }
      if (lane == 0) xsc[row] = am * (1.f / 127.f);
    }
  };
  u32x4 sA[NR], sB[NR], rA[2], rB[2];
  int row = gw;
  if (row >= nrows) return;
  load(row, sA, rA);
  while (true) {
    load(row + nw, sB, rB);
    process(row, sA, rA);
    row += nw;
    if (row >= nrows) break;
    load(row + nw, sA, rA);
    process(row, sB, rB);
    row += nw;
    if (row >= nrows) break;
  }
}

template <bool I8>
DI void quant_rows(const float* __restrict__ src, uint32_t* __restrict__ dst, float* __restrict__ scale, int nrows, const int WAVE_S) {
  const int tidq = tid_opaque();
  const int lane = tidq & 63;
  const int gw = (blockIdx.x * 256 + tidq) >> 6;
  const int nw = gridDim.x * 4;
  for (int row = gw; row < nrows; row += nw) {
    const float4* s4 = (const float4*)(src + (size_t)row * DM);
    float4 v[4];
#pragma unroll
    for (int i = 0; i < 4; ++i) v[i] = s4[lane + 64 * i];
    float am = 0.f;
#pragma unroll
    for (int i = 0; i < 4; ++i) am = fmaxf(am, fmaxf(fmaxf(fabsf(v[i].x), fabsf(v[i].y)), fmaxf(fabsf(v[i].z), fabsf(v[i].w))));
#pragma unroll
    for (int o = 32; o > 0; o >>= 1) am = fmaxf(am, shx(am, o, lane));
    am = fmaxf(am, 1e-20f);
    const float qmax = I8 ? 127.f : 224.f;
    const float inv = qmax / am;
    const int l = row / NEXP, e = row % NEXP;
#pragma unroll
    for (int i = 0; i < 4; ++i) {
      const int sl = 2 * i + (lane >> 5);
      dst[((size_t)(l * 8 + sl) * NEXP + e) * 32 + (lane & 31)] = I8 ? pk4_i8(v[i].x * inv, v[i].y * inv, v[i].z * inv, v[i].w * inv)
                                                                    : pk4_fp8(v[i].x * inv, v[i].y * inv, v[i].z * inv, v[i].w * inv);
    }
    if (lane == 0) scale[row] = am / qmax;
  }
}

DI void transpose_cvt(const float* __restrict__ src, u16* __restrict__ dst, int N, float* lds, const int WAVE_S) {
  const int tilesN = N / 64;
  const int ntiles = NLAYER * 16 * tilesN;
  const int tidt = tid_opaque();
  const int c = tidt & 63, r0 = tidt >> 6;
  for (int t = blockIdx.x; t < ntiles; t += gridDim.x) {
    const int l = t / (16 * tilesN);
    const int r = t % (16 * tilesN);
    const int kt = r / tilesN, nt = r % tilesN;
    const float* s = src + ((size_t)l * DM + kt * 64) * N + nt * 64;
    __syncthreads();
#pragma unroll
    for (int it = 0; it < 16; ++it) { const int kr = r0 + 4 * it; lds[kr * 65 + c] = s[(size_t)kr * N + c]; }
    __syncthreads();
    u16* d = dst + ((size_t)l * N + nt * 64) * DM + kt * 64;
#pragma unroll
    for (int it = 0; it < 16; ++it) { const int nr = r0 + 4 * it; d[(size_t)nr * DM + c] = f2bf(lds[c * 65 + nr]); }
  }
}

DI void prologue(const Params& p, float* ldsf, const int WAVE_S) {
  ln_rows<0, false, false>(p.x, nullptr, p.hb(), nullptr, nullptr, nullptr, p.ln_in_g, p.ln_in_b, T_TOK, WAVE_S);
  quant_rows<true>(p.peer_u, (uint32_t*)p.uq(), p.uscale(), NLAYER * NEXP, WAVE_S);
  quant_rows<false>(p.peer_v, (uint32_t*)p.vq(), p.vscale(), NLAYER * NEXP, WAVE_S);
  transpose_cvt(p.w_in, p.WinT(), 1536, ldsf, WAVE_S);
  transpose_cvt(p.w_o, p.WoT(), 1024, ldsf, WAVE_S);
  const int gt = blockIdx.x * 256 + tid_opaque(), gn = gridDim.x * 256;
  for (int i = gt; i < NLAYER * 8 * 2 * 128 * 128; i += gn) p.keysP()[i] = f2bf(p.peer_keys[i]);
  for (int i4 = gt; i4 < NLAYER * DM * 2048 / 4; i4 += gn) {
    const int i = i4 * 4;
    const int qcol = i & 2047, k = (i >> 11) & 1023, l = i >> 21;
    const float4 v = ((const float4*)p.peer_wq)[i4];
    *(uint2*)(p.wqP() + (((size_t)(l * 16 + (qcol >> 7)) * 1024 + k) * 128 + (qcol & 127))) = make_uint2(pk2(v.x, v.y), pk2(v.z, v.w));
  }
  for (int i = gt; i < SEQ * 32; i += gn) {
    const int s = i >> 5, a = (i >> 4) & 1, f = i & 15;
    const float pos = (float)(a ? (s & 63) : (s >> 6));
    const float inv = powf(10000.0f, -(float)f / 16.0f);
    const float ang = pos * inv;
    p.rope()[i] = cosf(ang);
    p.rope()[SEQ * 32 + i] = sinf(ang);
  }
}

template <int TI, int TJ, int NKT = 16, int RS = DM>
DI void gemm_tile(const u16* __restrict__ X, const u16* __restrict__ Y, f32x16 (&acc)[TI][TJ], u16* lds, int wi0, int wj0, const int WAVE_S) {
  const int tid = tid_opaque(), lane = tid & 63;
  u16* Xs = lds;
  u16* Ys = lds + 128 * LSTR;
  const int lr = tid >> 3, lc = (tid & 7) * 8;
  const u16* xg = X + (size_t)lr * RS + lc;
  const u16* yg = Y + (size_t)lr * RS + lc;
  u32x4 xr[4], yr[4];
#pragma unroll
  for (int it = 0; it < 4; ++it) {
    xr[it] = *(const u32x4*)(xg + (size_t)it * 32 * RS);
    yr[it] = *(const u32x4*)(yg + (size_t)it * 32 * RS);
  }
#pragma unroll
  for (int a = 0; a < TI; ++a)
#pragma unroll
    for (int b = 0; b < TJ; ++b)
#pragma unroll
      for (int r = 0; r < 16; ++r) acc[a][b][r] = 0.f;
  const int fr = lane & 31, fh = (lane >> 5) * 8;
  for (int kt = 0; kt < NKT; ++kt) {
    __syncthreads();
#pragma unroll
    for (int it = 0; it < 4; ++it) {
      *(u32x4*)(Xs + (lr + 32 * it) * LSTR + lc) = xr[it];
      *(u32x4*)(Ys + (lr + 32 * it) * LSTR + lc) = yr[it];
    }
    __syncthreads();
    if (kt + 1 < NKT) {
#pragma unroll
      for (int it = 0; it < 4; ++it) {
        xr[it] = *(const u32x4*)(xg + (size_t)it * 32 * RS + (kt + 1) * 64);
        yr[it] = *(const u32x4*)(yg + (size_t)it * 32 * RS + (kt + 1) * 64);
      }
    }
#pragma unroll
    for (int ks = 0; ks < 4; ++ks) {
      bf16x8 af[TI], bfr[TJ];
#pragma unroll
      for (int a = 0; a < TI; ++a) af[a] = *(const bf16x8*)(Xs + (wi0 + a * 32 + fr) * LSTR + ks * 16 + fh);
#pragma unroll
      for (int b = 0; b < TJ; ++b) bfr[b] = *(const bf16x8*)(Ys + (wj0 + b * 32 + fr) * LSTR + ks * 16 + fh);
#pragma unroll
      for (int a = 0; a < TI; ++a)
#pragma unroll
        for (int b = 0; b < TJ; ++b) acc[a][b] = MFMA32(af[a], bfr[b], acc[a][b]);
    }
    __builtin_amdgcn_iglp_opt(1);
  }
}

DI int next_item(unsigned* ctr, const int WAVE_S) {
  __shared__ int s_item;
  __syncthreads();
  if (tid_opaque() == 0) s_item = (int)__hip_atomic_fetch_add(ctr, 1u, __ATOMIC_RELAXED, __HIP_MEMORY_SCOPE_AGENT);
  __syncthreads();
  return s_item;
}

DI void fold_peer_weights(const Params& p, u16* lds, const int WAVE_S) {
  const int tid0 = tid_opaque();
  const int lane = tid0 & 63, wave = tid0 >> 6;
  const int r = lane & 31, h = lane >> 5;
  const int wi0 = (wave >> 1) * 64, wj0 = (wave & 1) * 64;
  for (int t = blockIdx.x; t < NLAYER * 16 * 8; t += gridDim.x) {
    const int lhp = t >> 3, kb = t & 7;
    f32x16 acc[2][2];
    gemm_tile<2, 2, 2, 128>(p.wqP() + ((size_t)lhp * 1024 + kb * 128) * 128, p.keysP() + (size_t)lhp * 128 * 128, acc, lds, wi0, wj0, WAVE_S);
    __syncthreads();
    u16* wl = lds + wave * 64 * LSTR;
#pragma unroll
    for (int tj = 0; tj < 2; ++tj)
#pragma unroll
      for (int ti = 0; ti < 2; ++ti)
#pragma unroll
        for (int g4 = 0; g4 < 4; ++g4)
          *(uint2*)(wl + (tj * 32 + r) * LSTR + ti * 32 + 8 * g4 + 4 * h) =
              make_uint2(pk2(acc[ti][tj][4 * g4 + 0], acc[ti][tj][4 * g4 + 1]), pk2(acc[ti][tj][4 * g4 + 2], acc[ti][tj][4 * g4 + 3]));
    u16* dst = p.WqT() + ((size_t)lhp * 128 + wj0) * DM + kb * 128 + wi0;
#pragma unroll
    for (int it = 0; it < 8; ++it) {
      const int row = it * 8 + (lane >> 3), ch = lane & 7;
      *(u32x4*)(dst + (size_t)row * DM + ch * 8) = *(const u32x4*)(wl + row * LSTR + ch * 8);
    }
  }
}

DI void phase_proj(const Params& p, int layer, u16* lds, const int WAVE_S) {
  const int tid0 = tid_opaque();
  const int lane = tid0 & 63, wave = tid0 >> 6;
  const int r = lane & 31, h = lane >> 5;
  const int wi0 = (wave >> 1) * 64, wj0 = (wave & 1) * 64;
  if (layer == 0) fold_peer_weights(p, lds, WAVE_S);
  const u16* W = p.WinT() + (size_t)layer * 1536 * DM;
  const int xcd = blockIdx.x & 7;
  unsigned* ctr = p.bar() + (3 * 2 + layer) * 8 + xcd;
  for (;;) {
    const int slot = next_item(ctr, WAVE_S);
    if (slot >= 768) break;
    const int ft = slot % 12, tt = (slot / 12) * 8 + xcd;
    f32x16 acc[2][2];
    gemm_tile<2, 2>(W + (size_t)ft * 128 * DM, p.hb() + (size_t)tt * 128 * DM, acc, lds, wi0, wj0, WAVE_S);
    const int hit = wave >> 1;
    int type, grp, head;
    if (ft < 4) { type = 0; grp = 0; head = ft * 2 + hit; }
    else if (ft == 4) { type = 1; grp = 0; head = hit; }
    else if (ft == 5) { type = 2; grp = 0; head = hit; }
    else if (ft < 10) { type = 0; grp = 1; head = (ft - 6) * 2 + hit; }
    else if (ft == 10) { type = 1; grp = 1; head = hit; }
    else { type = 2; grp = 1; head = hit; }
    __syncthreads();
    u16* wl = lds + wave * 64 * LSTR;
#pragma unroll
    for (int tj = 0; tj < 2; ++tj) {
      const int token = tt * 128 + wj0 + tj * 32 + r;
      const int s = token & 2047;
      if (type == 2) {
#pragma unroll
        for (int ti = 0; ti < 2; ++ti)
#pragma unroll
          for (int i = 0; i < 16; ++i) {
            const int d = ti * 32 + (i & 3) + 8 * (i >> 2) + 4 * h;
            wl[d * LSTR + swz16(tj * 32 + r)] = f2bf(acc[ti][tj][i]);
          }
      } else {
        float v[2][16];
        if (grp == 0) {
          float ss = 0.f;
#pragma unroll
          for (int ti = 0; ti < 2; ++ti)
#pragma unroll
            for (int i = 0; i < 16; ++i) ss += acc[ti][tj][i] * acc[ti][tj][i];
          ss += xhalf(ss);
          const float rs = rsqrtf(ss * (1.f / 64.f) + 1e-6f);
          const float* gw = (type == 0 ? p.qn_g : p.kn_g) + layer * 64;
#pragma unroll
          for (int ti = 0; ti < 2; ++ti)
#pragma unroll
            for (int g4 = 0; g4 < 4; ++g4) {
              const float4 gg = *(const float4*)(gw + ti * 32 + 8 * g4 + 4 * h);
              v[ti][4 * g4 + 0] = acc[ti][tj][4 * g4 + 0] * rs * gg.x;
              v[ti][4 * g4 + 1] = acc[ti][tj][4 * g4 + 1] * rs * gg.y;
              v[ti][4 * g4 + 2] = acc[ti][tj][4 * g4 + 2] * rs * gg.z;
              v[ti][4 * g4 + 3] = acc[ti][tj][4 * g4 + 3] * rs * gg.w;
            }
#pragma unroll
          for (int ti = 0; ti < 2; ++ti)
#pragma unroll
            for (int g4 = 0; g4 < 2; ++g4) {
              const float4 cc = *(const float4*)(p.rope() + (s * 2 + ti) * 16 + 8 * g4 + 4 * h);
              const float4 sn = *(const float4*)(p.rope() + SEQ * 32 + (s * 2 + ti) * 16 + 8 * g4 + 4 * h);
              const float c4[4] = {cc.x, cc.y, cc.z, cc.w};
              const float s4[4] = {sn.x, sn.y, sn.z, sn.w};
#pragma unroll
              for (int jj = 0; jj < 4; ++jj) {
                const float x1 = v[ti][4 * g4 + jj], x2 = v[ti][4 * g4 + jj + 8];
                v[ti][4 * g4 + jj] = x1 * c4[jj] - x2 * s4[jj];
                v[ti][4 * g4 + jj + 8] = x1 * s4[jj] + x2 * c4[jj];
              }
            }
        } else {
#pragma unroll
          for (int ti = 0; ti < 2; ++ti)
#pragma unroll
            for (int i = 0; i < 16; ++i) v[ti][i] = acc[ti][tj][i];
        }
        const float sc = (type == 0) ? QSCALE : 1.0f;
#pragma unroll
        for (int ti = 0; ti < 2; ++ti)
#pragma unroll
          for (int g4 = 0; g4 < 4; ++g4)
            *(uint2*)(wl + (tj * 32 + r) * LSTR + ti * 32 + 8 * g4 + 4 * h) =
                make_uint2(pk2(v[ti][4 * g4 + 0] * sc, v[ti][4 * g4 + 1] * sc), pk2(v[ti][4 * g4 + 2] * sc, v[ti][4 * g4 + 3] * sc));
      }
    }
    {
      const int token0 = tt * 128 + wj0;
      const int b = token0 >> 11, s0 = token0 & 2047;
      u16* dst;
      size_t rstride;
      if (type == 2) { dst = p.vtbuf() + ((size_t)(grp * 32 + b) * 2 + head) * 64 * SEQ + s0; rstride = SEQ; }
      else if (type == 0) { dst = p.qbuf() + (((size_t)(grp * 32 + b) * 8 + head) * SEQ + s0) * 64; rstride = 64; }
      else { dst = p.kbuf() + (((size_t)(grp * 32 + b) * 2 + head) * SEQ + s0) * 64; rstride = 64; }
#pragma unroll
      for (int it = 0; it < 8; ++it) {
        const int row = it * 8 + (lane >> 3), ch = lane & 7;
        *(u32x4*)(dst + (size_t)row * rstride + ch * 8) = *(const u32x4*)(wl + row * LSTR + ch * 8);
      }
    }
  }
}

template <int MODE>
DI void attn_item(const Params& p, int layer, int b, int hq, int qb, u16* lds, const int WAVE_S) {
  const int tid = tid_opaque(), lane = tid & 63, wave = tid >> 6;
  const int r = lane & 31, h = lane >> 5;
  const int kvh = hq >> 2;
  const int q0 = qb * 128 + wave * 32;
  const u16* qp = p.qbuf() + (((size_t)(MODE * 32 + b) * 8 + hq) * SEQ + q0 + r) * 64;
  const u16* kp = p.kbuf() + ((size_t)(MODE * 32 + b) * 2 + kvh) * SEQ * 64;
  const u16* vp = p.vtbuf() + ((size_t)(MODE * 32 + b) * 2 + kvh) * 64 * SEQ;
  bf16x8 qf[4];
#pragma unroll
  for (int ks = 0; ks < 4; ++ks) qf[ks] = *(const bf16x8*)(qp + ks * 16 + h * 8);
  int t_begin, t_end, kbase0;
  if (MODE == 0) { t_begin = 0; t_end = 32; kbase0 = 0; }
  else { t_begin = (qb == 0) ? 2 : 0; t_end = (qb == 15) ? 4 : 6; kbase0 = qb * 128 - 128; }
  float m_run, l_run;
  float slope2 = 0.f;
  if (MODE == 0) { m_run = 0.f; l_run = 0.f; }
  else {
    m_run = p.sink[layer * 8 + hq] * LOG2E;
    l_run = (h == 0) ? 1.f : 0.f;
    slope2 = exp2f(-(float)(hq + 1)) * LOG2E;
  }
  f32x16 negm;
#pragma unroll
  for (int i = 0; i < 16; ++i) negm[i] = -m_run;
  f32x16 o[2];
#pragma unroll
  for (int dt = 0; dt < 2; ++dt)
#pragma unroll
    for (int i = 0; i < 16; ++i) o[dt][i] = 0.f;
  const int lr = tid >> 3, lc = (tid & 7) * 8;
  u32x4 kr[2], vr[2];
  {
    const int kb = kbase0 + t_begin * 64;
#pragma unroll
    for (int it = 0; it < 2; ++it) {
      kr[it] = *(const u32x4*)(kp + (size_t)(kb + lr + 32 * it) * 64 + lc);
      vr[it] = *(const u32x4*)(vp + (size_t)(lr + 32 * it) * SEQ + kb + lc);
    }
  }
  __syncthreads();
  {
    u16* K0 = lds + (t_begin & 1) * 128 * LSTR;
#pragma unroll
    for (int it = 0; it < 2; ++it) {
      *(u32x4*)(K0 + (lr + 32 * it) * LSTR + lc) = kr[it];
      *(u32x4*)(K0 + 64 * LSTR + (lr + 32 * it) * LSTR + lc) = vr[it];
    }
    if (t_begin + 1 < t_end) {
      const int kb = kbase0 + (t_begin + 1) * 64;
#pragma unroll
      for (int it = 0; it < 2; ++it) {
        kr[it] = *(const u32x4*)(kp + (size_t)(kb + lr + 32 * it) * 64 + lc);
        vr[it] = *(const u32x4*)(vp + (size_t)(lr + 32 * it) * SEQ + kb + lc);
      }
    }
  }
  for (int t = t_begin; t < t_end; ++t) {
    __syncthreads();
    const u16* Ks = lds + (t & 1) * 128 * LSTR;
    const u16* Vs = Ks + 64 * LSTR;
    if (t + 1 < t_end) {
      u16* Kn = lds + ((t + 1) & 1) * 128 * LSTR;
#pragma unroll
      for (int it = 0; it < 2; ++it) {
        *(u32x4*)(Kn + (lr + 32 * it) * LSTR + lc) = kr[it];
        *(u32x4*)(Kn + 64 * LSTR + (lr + 32 * it) * LSTR + lc) = vr[it];
      }
      if (t + 2 < t_end) {
        const int kb = kbase0 + (t + 2) * 64;
#pragma unroll
        for (int it = 0; it < 2; ++it) {
          kr[it] = *(const u32x4*)(kp + (size_t)(kb + lr + 32 * it) * 64 + lc);
          vr[it] = *(const u32x4*)(vp + (size_t)(lr + 32 * it) * SEQ + kb + lc);
        }
      }
    }
    bool live = true;
    if (MODE == 1) {
      const int kb = kbase0 + t * 64;
      const int gap = (kb > q0 + 31) ? kb - (q0 + 31) : ((kb + 63 < q0) ? q0 - (kb + 63) : 0);
      live = gap <= 128;
    }
    if (live) {
    f32x16 sc[2];
#pragma unroll
    for (int k2 = 0; k2 < 2; ++k2) {
#pragma unroll
      for (int ks = 0; ks < 4; ++ks) {
        const bf16x8 kf = *(const bf16x8*)(Ks + (k2 * 32 + r) * LSTR + ks * 16 + h * 8);
        sc[k2] = (ks == 0) ? MFMA32(kf, qf[0], negm) : MFMA32(kf, qf[ks], sc[k2]);
      }
    }
    if (MODE == 1) {
      const float tposf = (float)(q0 + r - (kbase0 + t * 64) - 4 * h);
#pragma unroll
      for (int k2 = 0; k2 < 2; ++k2)
#pragma unroll
        for (int i = 0; i < 16; ++i) {
          const float dist = fabsf(tposf - (float)(k2 * 32 + (i & 3) + 8 * (i >> 2)));
          sc[k2][i] = (dist <= 128.f) ? (sc[k2][i] - slope2 * dist) : -1e30f;
        }
    }
    float mx0 = fmaxf(fmaxf(sc[0][0], sc[0][1]), sc[0][2]), mx1 = fmaxf(fmaxf(sc[1][0], sc[1][1]), sc[1][2]);
#pragma unroll
    for (int i = 3; i < 15; i += 2) { mx0 = fmaxf(fmaxf(mx0, sc[0][i]), sc[0][i + 1]); mx1 = fmaxf(fmaxf(mx1, sc[1][i]), sc[1][i + 1]); }
    float mx = fmaxf(fmaxf(mx0, mx1), fmaxf(sc[0][15], sc[1][15]));
    {
      auto rr = __builtin_amdgcn_permlane32_swap(__float_as_uint(mx), __float_as_uint(mx), false, false);
      mx = fmaxf(__uint_as_float(rr[0]), __uint_as_float(rr[1]));
    }
    if (__any(mx > 8.0f)) {
      const float delta = fmaxf(mx, 0.f);
      const float al = __builtin_amdgcn_exp2f(-delta);
#pragma unroll
      for (int k2 = 0; k2 < 2; ++k2)
#pragma unroll
        for (int i = 0; i < 16; ++i) sc[k2][i] -= delta;
#pragma unroll
      for (int dt = 0; dt < 2; ++dt)
#pragma unroll
        for (int i = 0; i < 16; ++i) o[dt][i] *= al;
      l_run *= al;
      m_run += delta;
#pragma unroll
      for (int i = 0; i < 16; ++i) negm[i] = -m_run;
    }
    f32x2_t ps2 = {0.f, 0.f};
#pragma unroll
    for (int k2 = 0; k2 < 2; ++k2)
#pragma unroll
      for (int i = 0; i < 16; i += 2) {
        const float e0 = __builtin_amdgcn_exp2f(sc[k2][i]), e1 = __builtin_amdgcn_exp2f(sc[k2][i + 1]);
        sc[k2][i] = e0;
        sc[k2][i + 1] = e1;
        ps2 += (f32x2_t){e0, e1};
      }
    l_run += ps2[0] + ps2[1];
    bf16x8 pf[2][2];
#pragma unroll
    for (int k2 = 0; k2 < 2; ++k2)
#pragma unroll
      for (int st = 0; st < 2; ++st) pf[k2][st] = pack8(sc[k2], st);
#pragma unroll
    for (int dt = 0; dt < 2; ++dt)
#pragma unroll
      for (int k2 = 0; k2 < 2; ++k2)
#pragma unroll
        for (int st = 0; st < 2; ++st) {
          const bf16x8 vf = *(const bf16x8*)(Vs + (dt * 32 + r) * LSTR + k2 * 32 + st * 16 + h * 8);
          o[dt] = MFMA32(vf, pf[k2][st], o[dt]);
        }
    }
  }
  const float lt = l_run + xhalf(l_run);
  const float inv = 1.f / lt;
  float ss = 0.f;
#pragma unroll
  for (int dt = 0; dt < 2; ++dt)
#pragma unroll
    for (int i = 0; i < 16; ++i) { o[dt][i] *= inv; ss += o[dt][i] * o[dt][i]; }
  ss += xhalf(ss);
  const float rs = rsqrtf(ss * (1.f / 64.f) + 1e-6f);
  const float* gn = (MODE == 0 ? p.gn_a_g : p.gn_b_g) + layer * 512 + hq * 64;
  u16* dst = p.ob() + ((size_t)b * SEQ + q0 + r) * DM + MODE * 512 + hq * 64;
#pragma unroll
  for (int dt = 0; dt < 2; ++dt)
#pragma unroll
    for (int g4 = 0; g4 < 4; ++g4) {
      const int d = dt * 32 + 8 * g4 + 4 * h;
      const float4 gg = *(const float4*)(gn + d);
      *(uint2*)(dst + d) = make_uint2(pk2(o[dt][4 * g4 + 0] * rs * gg.x, o[dt][4 * g4 + 1] * rs * gg.y),
                                      pk2(o[dt][4 * g4 + 2] * rs * gg.z, o[dt][4 * g4 + 3] * rs * gg.w));
    }
}

DI void phase_attn(const Params& p, int layer, u16* lds, const int WAVE_S) {
  const int xcd = blockIdx.x & 7;
  unsigned* ctr = p.bar() + (0 * 2 + layer) * 8 + xcd;
  for (;;) {
    const int it = next_item(ctr, WAVE_S);
    if (it >= 1024) break;
    const int mode = it >> 9, slot = it & 511;
    const int grp = (slot >> 6) * 8 + xcd;
    const int within = slot & 63;
    const int b = grp >> 1, kvh = grp & 1;
    const int hq = kvh * 4 + (within >> 4), qb = within & 15;
    if (mode == 0) attn_item<0>(p, layer, b, hq, qb, lds, WAVE_S);
    else attn_item<1>(p, layer, b, hq, qb, lds, WAVE_S);
  }
}

DI void phase_wo(const Params& p, int layer, u16* lds, const int WAVE_S) {
  const int tid0 = tid_opaque();
  const int lane = tid0 & 63, wave = tid0 >> 6;
  const int r = lane & 31, h = lane >> 5;
  const int wi0 = (wave >> 1) * 64, wj0 = (wave & 1) * 64;
  const u16* W = p.WoT() + (size_t)layer * 1024 * DM;
  const int xcd = blockIdx.x & 7;
  unsigned* ctr = p.bar() + (1 * 2 + layer) * 8 + xcd;
  for (;;) {
    const int slot = next_item(ctr, WAVE_S);
    if (slot >= 512) break;
    const int ft = slot & 7, tt = (slot >> 3) * 8 + xcd;
    f32x16 acc[2][2];
    gemm_tile<2, 2>(W + (size_t)ft * 128 * DM, p.ob() + (size_t)tt * 128 * DM, acc, lds, wi0, wj0, WAVE_S);
    __syncthreads();
    u16* wl = lds + wave * 64 * LSTR;
#pragma unroll
    for (int tj = 0; tj < 2; ++tj)
#pragma unroll
      for (int ti = 0; ti < 2; ++ti)
#pragma unroll
        for (int g4 = 0; g4 < 4; ++g4)
          *(uint2*)(wl + (tj * 32 + r) * LSTR + ti * 32 + 8 * g4 + 4 * h) =
              make_uint2(pk2(acc[ti][tj][4 * g4 + 0], acc[ti][tj][4 * g4 + 1]), pk2(acc[ti][tj][4 * g4 + 2], acc[ti][tj][4 * g4 + 3]));
    u16* dst = p.yb() + (size_t)(tt * 128 + wj0) * DM + ft * 128 + wi0;
#pragma unroll
    for (int it = 0; it < 8; ++it) {
      const int row = it * 8 + (lane >> 3), ch = lane & 7;
      *(u32x4*)(dst + (size_t)row * DM + ch * 8) = *(const u32x4*)(wl + row * LSTR + ch * 8);
    }
  }
}

DI void phase_peer_q(const Params& p, int layer, u16* lds, const int WAVE_S) {
  const int tid0 = tid_opaque();
  const int lane = tid0 & 63, wave = tid0 >> 6;
  const int r = lane & 31, h = lane >> 5;
  const u16* W = p.WqT() + (size_t)layer * 2048 * DM;
  const int xcd = blockIdx.x & 7;
  unsigned* ctr = p.bar() + (2 * 2 + layer) * 8 + xcd;
  for (;;) {
    const int slot = next_item(ctr, WAVE_S);
    if (slot >= 512) break;
    const int head = slot & 7, tt = (slot >> 3) * 8 + xcd;
    float t0[16], t[16];
#pragma unroll 1
    for (int half = 0; half < 2; ++half) {
      f32x16 acc[4][1];
      gemm_tile<4, 1>(W + (size_t)(head * 2 + half) * 128 * DM, p.hb() + (size_t)tt * 128 * DM, acc, lds, 0, wave * 32, WAVE_S);
#pragma unroll
      for (int i = 0; i < 16; ++i) t[i] = -3.0e38f;
#pragma unroll
      for (int nt = 0; nt < 4; ++nt)
#pragma unroll
        for (int i = 0; i < 16; ++i) {
          const uint32_t n = nt * 32 + (i & 3) + 8 * (i >> 2) + 4 * h;
          const float v = __uint_as_float((__float_as_uint(acc[nt][0][i]) & ~127u) | n);
          ins16n(t, v, nt * 16 + i);
        }
      float o16[16];
#pragma unroll
      for (int i = 0; i < 16; ++i) {
        auto rr = __builtin_amdgcn_permlane32_swap(__float_as_uint(t[i]), __float_as_uint(t[i]), false, false);
        o16[i] = __uint_as_float(h ? rr[0] : rr[1]);
      }
#pragma unroll
      for (int i = 0; i < 16; ++i) ins16(t, o16[i]);
      if (half == 0) {
#pragma unroll
        for (int i = 0; i < 16; ++i) t0[i] = t[i];
      }
    }
    float c[16];
#pragma unroll
    for (int i = 0; i < 16; ++i) c[i] = -3.0e38f;
#pragma unroll
    for (int i = 0; i < 16; ++i)
#pragma unroll
      for (int j = 0; j < 16; ++j)
        if ((i + 1) * (j + 1) <= 16) {
          const float sv = t0[i] + t[j];
          ins16(c, __uint_as_float((__float_as_uint(sv) & ~255u) | (uint32_t)(i * 16 + j)));
        }
    __syncthreads();
    uint32_t* wl = (uint32_t*)lds + wave * (32 * 33);
    if (h == 0) {
#pragma unroll
      for (int i = 0; i < 16; ++i) { wl[r * 33 + i] = __float_as_uint(t0[i]); wl[r * 33 + 16 + i] = __float_as_uint(t[i]); }
    }
    float sv[16];
    uint32_t ev[16];
    float smax = -3.0e38f;
#pragma unroll
    for (int k = 0; k < 16; ++k) {
      const uint32_t pos = __float_as_uint(c[k]) & 255u;
      const uint32_t ai = wl[r * 33 + (pos >> 4)];
      const uint32_t bj = wl[r * 33 + 16 + (pos & 15)];
      sv[k] = __uint_as_float(ai & ~127u) + __uint_as_float(bj & ~127u);
      ev[k] = ((ai & 127u) << 7) | (bj & 127u);
      smax = fmaxf(smax, sv[k]);
    }
    float ssum = 0.f;
#pragma unroll
    for (int k = 0; k < 16; ++k) { sv[k] = __expf(sv[k] - smax); ssum += sv[k]; }
    const float rinv = 1.f / ssum;
    const int tq = tid_opaque();
    const size_t item = (size_t)(tt * 128 + (tq >> 6) * 32 + (tq & 31)) * 8 + head;
    if (((tq >> 5) & 1) == 0) {
      u32x4* de = (u32x4*)(p.sel_e() + item * 16);
#pragma unroll
      for (int g4 = 0; g4 < 2; ++g4) {
        u32x4 w;
#pragma unroll
        for (int j = 0; j < 4; ++j) w[j] = ev[8 * g4 + 2 * j] | (ev[8 * g4 + 2 * j + 1] << 16);
        de[g4] = w;
      }
    } else {
      f32x4* dg = (f32x4*)(p.sel_g() + item * 16);
#pragma unroll
      for (int g4 = 0; g4 < 4; ++g4) {
        f32x4 w = {sv[4 * g4] * rinv, sv[4 * g4 + 1] * rinv, sv[4 * g4 + 2] * rinv, sv[4 * g4 + 3] * rinv};
        dg[g4] = w;
      }
    }
  }
}

DI void phase_peer_merge(const Params& p, const int WAVE_S) {
  const int gt = blockIdx.x * 256 + tid_opaque(), gn = gridDim.x * 256;
  for (int item = gt; item < T_TOK * 8; item += gn) {
    const uint32_t* tkp = p.tk() + (size_t)item * 32;
    float a[16], bb[16];
#pragma unroll
    for (int g4 = 0; g4 < 4; ++g4) {
      const u32x4 ua = ((const u32x4*)tkp)[g4];
      const u32x4 ubv = ((const u32x4*)tkp)[4 + g4];
#pragma unroll
      for (int j = 0; j < 4; ++j) { a[4 * g4 + j] = __uint_as_float(ua[j]); bb[4 * g4 + j] = __uint_as_float(ubv[j]); }
    }
    float c[16];
#pragma unroll
    for (int i = 0; i < 16; ++i) c[i] = -3.0e38f;
#pragma unroll
    for (int i = 0; i < 16; ++i)
#pragma unroll
      for (int j = 0; j < 16; ++j)
        if ((i + 1) * (j + 1) <= 16) {
          const float sv = a[i] + bb[j];
          ins16(c, __uint_as_float((__float_as_uint(sv) & ~255u) | (uint32_t)(i * 16 + j)));
        }
    float sv[16];
    uint32_t ev[16];
    float smax = -3.0e38f;
#pragma unroll
    for (int k = 0; k < 16; ++k) {
      const uint32_t pos = __float_as_uint(c[k]) & 255u;
      const uint32_t ai = tkp[pos >> 4];
      const uint32_t bj = tkp[16 + (pos & 15)];
      sv[k] = __uint_as_float(ai & ~127u) + __uint_as_float(bj & ~127u);
      ev[k] = ((ai & 127u) << 7) | (bj & 127u);
      smax = fmaxf(smax, sv[k]);
    }
    float ssum = 0.f;
#pragma unroll
    for (int k = 0; k < 16; ++k) { sv[k] = __expf(sv[k] - smax); ssum += sv[k]; }
    const float rinv = 1.f / ssum;
    u32x4* de = (u32x4*)(p.sel_e() + (size_t)item * 16);
    f32x4* dg = (f32x4*)(p.sel_g() + (size_t)item * 16);
#pragma unroll
    for (int g4 = 0; g4 < 2; ++g4) {
      u32x4 w;
#pragma unroll
      for (int j = 0; j < 4; ++j) w[j] = ev[8 * g4 + 2 * j] | (ev[8 * g4 + 2 * j + 1] << 16);
      de[g4] = w;
    }
#pragma unroll
    for (int g4 = 0; g4 < 4; ++g4) {
      f32x4 w = {sv[4 * g4] * rinv, sv[4 * g4 + 1] * rinv, sv[4 * g4 + 2] * rinv, sv[4 * g4 + 3] * rinv};
      dg[g4] = w;
    }
  }
}

DI void phase_peer_u(const Params& p, int layer, const int WAVE_S) {
  const int tid = tid_opaque();
  const int lane = tid & 63, wave = tid >> 6;
  const int slice = blockIdx.x & 7;
  const int wv = (blockIdx.x >> 3) * 4 + wave;
  const int nwv = ((gridDim.x - slice + 7) >> 3) * 4;
  const int es = lane >> 3, c = lane & 7;
  const uint8_t* ubase = p.uq() + (size_t)(layer * 8 + slice) * NEXP * 128;
  const uint32_t coff = (uint32_t)c << 4;
  u16* part = p.partial() + (size_t)slice * T_TOK * 128;
  const bool b2 = (lane >> 2) & 1, b1 = (lane >> 1) & 1, b0 = lane & 1;
  auto load_se = [&](int token, u32x4& se0, u32x4& se1) {
    token = token < T_TOK ? token : T_TOK - 1;
    se0 = *(const u32x4*)(p.sel_e() + (size_t)token * 128 + es * 16);
    se1 = *(const u32x4*)(p.sel_e() + (size_t)token * 128 + es * 16 + 8);
  };
  auto load_x = [&](int token) -> u32x4 {
    token = token < T_TOK ? token : T_TOK - 1;
    return *(const u32x4*)(p.xq() + ((size_t)slice * T_TOK + token) * 128 + c * 16);
  };
  auto load_half = [&](const u32x4& se, u32x4 (&vv)[8]) {
#pragma unroll
    for (int it = 0; it < 8; ++it) {
      const uint32_t e = (se[it >> 1] >> (16 * (it & 1))) & 0xffffu;
      vv[it] = *(const u32x4*)(ubase + ((e << 7) | coff));
    }
  };
  auto dot_half = [&](const u32x4 (&vv)[8], const u32x4& xq, int (&ds)[8]) {
#pragma unroll
    for (int it = 0; it < 8; ++it) {
      int a = 0;
#pragma unroll
      for (int dw = 0; dw < 4; ++dw) a = __builtin_amdgcn_sdot4((int)vv[it][dw], (int)xq[dw], a, false);
      ds[it] = a;
    }
  };
  auto finish = [&](int token, const int (&lo)[8], const int (&hi)[8]) {
    int r8[8], r4[4], r2[2];
#pragma unroll
    for (int k = 0; k < 8; ++k) {
      const int send = b2 ? lo[k] : hi[k], keep = b2 ? hi[k] : lo[k];
      r8[k] = keep + shxi(send, 4, lane);
    }
#pragma unroll
    for (int k = 0; k < 4; ++k) {
      const int send = b1 ? r8[k] : r8[k + 4], keep = b1 ? r8[k + 4] : r8[k];
      r4[k] = keep + shxi(send, 2, lane);
    }
#pragma unroll
    for (int k = 0; k < 2; ++k) {
      const int send = b0 ? r4[k] : r4[k + 2], keep = b0 ? r4[k + 2] : r4[k];
      r2[k] = keep + shxi(send, 1, lane);
    }
    *(uint32_t*)(part + (size_t)token * 128 + 2 * lane) = pk2((float)r2[0], (float)r2[1]);
  };
  u32x4 vA[8], vB[8], se0c, se1c, se0n, se1n, xc, xn;
  int t = wv;
  if (t >= T_TOK) return;
  load_se(t, se0c, se1c);
  xc = load_x(t);
  load_se(t + nwv, se0n, se1n);
  load_half(se0c, vA);
  for (;;) {
    int lo[8], hi[8];
    load_half(se1c, vB);
    dot_half(vA, xc, lo);
    load_half(se0n, vA);
    xn = load_x(t + nwv);
    dot_half(vB, xc, hi);
    finish(t, lo, hi);
    se0c = se0n; se1c = se1n; xc = xn;
    load_se(t + 2 * nwv, se0n, se1n);
    t += nwv;
    if (t >= T_TOK) break;
  }
}

DI void phase_peer_w(const Params& p, int layer, const int WAVE_S) {
  const int gt = blockIdx.x * 256 + tid_opaque(), gn = gridDim.x * 256;
  const float* us = p.uscale() + layer * NEXP;
  const float* vs = p.vscale() + layer * NEXP;
  for (int i4 = gt; i4 < T_TOK * 32; i4 += gn) {
    f32x4 sum = {0.f, 0.f, 0.f, 0.f};
#pragma unroll
    for (int sl = 0; sl < 8; ++sl) {
      const uint2 pv = ((const uint2*)(p.partial() + (size_t)sl * T_TOK * 128))[i4];
      sum += (f32x4){bflo(pv.x), bfhi(pv.x), bflo(pv.y), bfhi(pv.y)};
    }
    const uint2 ep = ((const uint2*)p.sel_e())[i4];
    const float xs = p.xscale()[i4 >> 5];
    const f32x4 gg = ((const f32x4*)p.sel_g())[i4];
    const uint32_t e[4] = {ep.x & 0xffffu, ep.x >> 16, ep.y & 0xffffu, ep.y >> 16};
    f32x4 w;
#pragma unroll
    for (int j = 0; j < 4; ++j) {
      const float a = sum[j] * us[e[j]] * xs;
      const float ge = 0.5f * a * (1.f + erff(a * 0.70710678118f));
      w[j] = gg[j] * ge * vs[e[j]];
    }
    ((f32x4*)p.wbuf())[i4] = w;
  }
}

DI void phase_peer_v(const Params& p, int layer, const int WAVE_S) {
  const int tid = tid_opaque();
  const int lane = tid & 63, wave = tid >> 6;
  const int slice = blockIdx.x & 7;
  const int wv = (blockIdx.x >> 3) * 4 + wave;
  const int nwv = ((gridDim.x - slice + 7) >> 3) * 4;
  const int es = lane >> 3, c = lane & 7;
  const uint8_t* vbase = p.vq() + (size_t)(layer * 8 + slice) * NEXP * 128;
  const uint32_t coff = (uint32_t)c << 4;
  const bool b5 = (lane >> 5) & 1, b4 = (lane >> 4) & 1, b3 = (lane >> 3) & 1;
  const int dl = 16 * c + 8 * (int)b5 + 4 * (int)b4 + 2 * (int)b3;
  auto load_se = [&](int token, u32x4& se0, u32x4& se1) {
    token = token < T_TOK ? token : T_TOK - 1;
    se0 = *(const u32x4*)(p.sel_e() + (size_t)token * 128 + es * 16);
    se1 = *(const u32x4*)(p.sel_e() + (size_t)token * 128 + es * 16 + 8);
  };
  auto load_w = [&](int token, f32x4 (&wv4)[4]) {
    token = token < T_TOK ? token : T_TOK - 1;
#pragma unroll
    for (int i = 0; i < 4; ++i) wv4[i] = *(const f32x4*)(p.wbuf() + (size_t)token * 128 + es * 16 + 4 * i);
  };
  auto load_half = [&](const u32x4& se, u32x4 (&vv)[8]) {
#pragma unroll
    for (int it = 0; it < 8; ++it) {
      const uint32_t e = (se[it >> 1] >> (16 * (it & 1))) & 0xffffu;
      vv[it] = *(const u32x4*)(vbase + ((e << 7) | coff));
    }
  };
  auto axpy_half = [&](const u32x4 (&vv)[8], const f32x4& w0, const f32x4& w1, f32x2_t (&acc)[8]) {
#pragma unroll
    for (int it = 0; it < 8; ++it) {
      const float w = (it < 4) ? w0[it & 3] : w1[it & 3];
      const f32x2_t w2 = {w, w};
#pragma unroll
      for (int dw = 0; dw < 4; ++dw) {
        const f32x2_t lo = __builtin_amdgcn_cvt_pk_f32_fp8((int)vv[it][dw], false);
        const f32x2_t hi = __builtin_amdgcn_cvt_pk_f32_fp8((int)vv[it][dw], true);
        acc[2 * dw] = __builtin_elementwise_fma(lo, w2, acc[2 * dw]);
        acc[2 * dw + 1] = __builtin_elementwise_fma(hi, w2, acc[2 * dw + 1]);
      }
    }
  };
  auto finish = [&](int token, const f32x2_t (&acc)[8]) {
    float r8[8], r4[4], r2[2];
#pragma unroll
    for (int k = 0; k < 8; ++k) {
      auto rr = __builtin_amdgcn_permlane32_swap(__float_as_uint(acc[k >> 1][k & 1]), __float_as_uint(acc[4 + (k >> 1)][k & 1]), false, false);
      r8[k] = __uint_as_float(rr[0]) + __uint_as_float(rr[1]);
    }
#pragma unroll
    for (int k = 0; k < 4; ++k) {
      auto rr = __builtin_amdgcn_permlane16_swap(__float_as_uint(r8[k]), __float_as_uint(r8[k + 4]), false, false);
      r4[k] = __uint_as_float(rr[0]) + __uint_as_float(rr[1]);
    }
#pragma unroll
    for (int k = 0; k < 2; ++k) {
      const float send = b3 ? r4[k] : r4[k + 2], keep = b3 ? r4[k + 2] : r4[k];
      r2[k] = keep + shx(send, 8, lane);
    }
    *(uint32_t*)(p.yb() + (size_t)token * DM + slice * 128 + dl) = pk2(r2[0], r2[1]);
  };
  u32x4 vA[8], vB[8], se0c, se1c, se0n, se1n;
  f32x4 wc[4], wn[4];
  int t = wv;
  if (t >= T_TOK) return;
  load_se(t, se0c, se1c);
  load_w(t, wc);
  load_se(t + nwv, se0n, se1n);
  load_half(se0c, vA);
  for (;;) {
    f32x2_t acc[8];
#pragma unroll
    for (int k = 0; k < 8; ++k) acc[k] = (f32x2_t){0.f, 0.f};
    load_half(se1c, vB);
    axpy_half(vA, wc[0], wc[1], acc);
    load_half(se0n, vA);
    load_w(t + nwv, wn);
    axpy_half(vB, wc[2], wc[3], acc);
    finish(t, acc);
    se0c = se0n; se1c = se1n;
#pragma unroll
    for (int i = 0; i < 4; ++i) wc[i] = wn[i];
    load_se(t + 2 * nwv, se0n, se1n);
    t += nwv;
    if (t >= T_TOK) break;
  }
}

#define XB_TMO      128
#define XB_XCNT(j)  (256  + 64 * (j))
#define XB_XSUB(j)  (1280 + 64 * (j))
#define XB_XGEN(j)  (2304 + 64 * (j))
#define XB_TOP      3328
#define XB_TOPGEN   3392
#define XCD_BAR_WORDS 3456
#define XB_SPIN_CAP (1u << 20)
#define LAS __attribute__((address_space(3)))
DI unsigned xb_ld(unsigned* p) { return __hip_atomic_load(p, __ATOMIC_RELAXED, __HIP_MEMORY_SCOPE_AGENT); }
DI unsigned xb_add(unsigned* p, unsigned v) { return __hip_atomic_fetch_add(p, v, __ATOMIC_RELAXED, __HIP_MEMORY_SCOPE_AGENT); }
DI unsigned xb_xcc_id() { return (unsigned)__builtin_amdgcn_s_getreg((3 << 11) | 20) & 0xFu; }
#define XB_SPIN(cond, bar) do { unsigned _sp = 0; while (cond) { __builtin_amdgcn_s_sleep(1); \
    if ((++_sp & 255u) == 0u) { if (xb_ld(&(bar)[XB_TMO])) break; if (_sp > XB_SPIN_CAP) { atomicAdd(&(bar)[XB_TMO], 1u); break; } } } } while (0)
struct XcdBarrier { unsigned* bar; unsigned x; volatile LAS unsigned* st; };
DI XcdBarrier xcd_barrier_post(unsigned* bar, volatile LAS unsigned* st, const int WAVE_S) {
  XcdBarrier b; b.bar = bar; b.x = xb_xcc_id(); b.st = st;
  if (tid_opaque() == 0) (void)xb_add(&bar[XB_XCNT(b.x)], 1u);
  return b;
}
DI void xcd_barrier_complete(unsigned* bar, unsigned x, unsigned& nloc, unsigned& nx) {
  const unsigned G = gridDim.x * gridDim.y * gridDim.z;
  unsigned sum, cnt, mine, sp = 0u;
  for (;;) {
    sum = 0u; cnt = 0u; mine = 0u;
#pragma unroll
    for (unsigned j = 0; j < 16; ++j) { const unsigned c = xb_ld(&bar[XB_XCNT(j)]); sum += c; cnt += (c > 0u) ? 1u : 0u; mine = (j == x) ? c : mine; }
    if (sum == G) break;
    __builtin_amdgcn_s_sleep(1);
    if ((++sp & 255u) == 0u) { if (xb_ld(&bar[XB_TMO])) break; if (sp > XB_SPIN_CAP) { atomicAdd(&bar[XB_TMO], 1u); break; } }
  }
  nloc = mine > 0u ? mine : 1u; nx = cnt > 0u ? cnt : 1u;
}
DI void xcd_barrier(const XcdBarrier& b, const int WAVE_S) {
  asm volatile("s_waitcnt vmcnt(0)" ::: "memory");
  __syncthreads();
  if (tid_opaque() == 0) {
    unsigned* bar = b.bar;
    __builtin_amdgcn_s_waitcnt(0);
    unsigned nloc = b.st[0], nx = b.st[1];
    if (nloc == 0u) { xcd_barrier_complete(bar, b.x, nloc, nx); b.st[0] = nloc; b.st[1] = nx; }
    const unsigned old = xb_add(&bar[XB_XSUB(b.x)], 1u);
    const unsigned gen = old / nloc;
    if (old + 1u == (gen + 1u) * nloc) {
      __builtin_amdgcn_fence(__ATOMIC_RELEASE, "agent");
      asm volatile("s_waitcnt vmcnt(0)" ::: "memory");
      const unsigned og = xb_add(&bar[XB_TOP], 1u);
      const unsigned tg = og / nx;
      if (og + 1u == (tg + 1u) * nx) xb_add(&bar[XB_TOPGEN], 1u);
      else XB_SPIN(xb_ld(&bar[XB_TOPGEN]) == tg, bar);
      __builtin_amdgcn_fence(__ATOMIC_ACQUIRE, "agent");
      xb_add(&bar[XB_XGEN(b.x)], 1u);
      asm volatile("s_waitcnt vmcnt(0)" ::: "memory");
    } else {
      XB_SPIN(xb_ld(&bar[XB_XGEN(b.x)]) == gen, bar);
      __builtin_amdgcn_fence(__ATOMIC_ACQUIRE, "agent");
      asm volatile("s_waitcnt vmcnt(0)" ::: "memory");
    }
  }
  __syncthreads();
}

__global__ void __launch_bounds__(256, 3) mega_kernel(Params p) {
  __shared__ __attribute__((aligned(16))) char lds[40960];
  __shared__ uint4 xb_words;
  cg::grid_group grid = cg::this_grid();
  const int WAVE_S = __builtin_amdgcn_readfirstlane((int)(threadIdx.x >> 6));
  if (tid_opaque() == 0) xb_words = make_uint4(0u, 0u, 0u, 0u);
  __syncthreads();
  const XcdBarrier xb = xcd_barrier_post(p.bar(), (volatile LAS unsigned*)&xb_words, WAVE_S);
  prologue(p, (float*)lds, WAVE_S);
  grid.sync();
  for (int layer = 0; layer < NLAYER; ++layer) {
    phase_proj(p, layer, (u16*)lds, WAVE_S);
    xcd_barrier(xb, WAVE_S);
    phase_attn(p, layer, (u16*)lds, WAVE_S);
    xcd_barrier(xb, WAVE_S);
    phase_wo(p, layer, (u16*)lds, WAVE_S);
    xcd_barrier(xb, WAVE_S);
    ln_rows<1, true, false>(p.yb(), p.hb(), p.hb(), (uint32_t*)p.xq(), p.xscale(), nullptr, p.ln1_g + layer * DM, p.ln1_b + layer * DM, T_TOK, WAVE_S);
    xcd_barrier(xb, WAVE_S);
    phase_peer_q(p, layer, (u16*)lds, WAVE_S);
    xcd_barrier(xb, WAVE_S);
    phase_peer_u(p, layer, WAVE_S);
    xcd_barrier(xb, WAVE_S);
    phase_peer_w(p, layer, WAVE_S);
    xcd_barrier(xb, WAVE_S);
    phase_peer_v(p, layer, WAVE_S);
    xcd_barrier(xb, WAVE_S);
    ln_rows<1, false, true>(p.yb(), p.hb(), layer == NLAYER - 1 ? nullptr : p.hb(), nullptr, nullptr, layer == NLAYER - 1 ? p.out : nullptr, p.ln2_g + layer * DM, p.ln2_b + layer * DM, T_TOK, WAVE_S);
    xcd_barrier(xb, WAVE_S);
  }
}

extern "C" void kernel_launch(void* const* d_in, const int* in_sizes, int n_in, void* d_out, int out_size, void* d_ws,
                              size_t ws_size, hipStream_t stream) {
  static int grid_blocks = 0;
  if (!grid_blocks) {
    int dev = 0, cus = 0, per_cu = 0;
    hipGetDevice(&dev);
    hipDeviceGetAttribute(&cus, hipDeviceAttributeMultiprocessorCount, dev);
    hipOccupancyMaxActiveBlocksPerMultiprocessor(&per_cu, mega_kernel, 256, 0);
    if (per_cu < 1) per_cu = 1;
    if (per_cu > 3) per_cu = 3;
    grid_blocks = cus * per_cu;
  }
  Params p{};
  const float* const* in = (const float* const*)d_in;
  p.x = in[0]; p.ln_in_g = in[1]; p.ln_in_b = in[2]; p.w_in = in[3]; p.qn_g = in[4]; p.kn_g = in[5]; p.sink = in[6];
  p.gn_a_g = in[7]; p.gn_b_g = in[8]; p.w_o = in[9]; p.ln1_g = in[10]; p.ln1_b = in[11]; p.peer_wq = in[12];
  p.peer_keys = in[13]; p.peer_u = in[14]; p.peer_v = in[15]; p.ln2_g = in[16]; p.ln2_b = in[17];
  p.out = (float*)d_out;
  p.ws = (char*)d_ws;
  if (WS_TOTAL > ws_size) fprintf(stderr, "workspace too small: need %zu have %zu\n", (size_t)WS_TOTAL, ws_size);
  (void)hipMemsetAsync((char*)d_ws + OFF_bar, 0, (size_t)XCD_BAR_WORDS * 4, stream);
  void* args[] = {&p};
  hipError_t e = hipLaunchCooperativeKernel((void*)mega_kernel, dim3(grid_blocks), dim3(256), args, 0, stream);
  if (e != hipSuccess) fprintf(stderr, "cooperative launch failed: %s (grid %d)\n", hipGetErrorString(e), grid_blocks);
}
```
